# Optimizing an MI355X kernel written in HIP

```python
import jax, jax.numpy as jnp
from jax import lax
import numpy as np

D_MODEL = 1024
BATCH = 8
SEQ = 8192
DEPTH = 1

N_META = 16
RET_HEADS = 4
RET_QK_DIM = D_MODEL // RET_HEADS
RET_WIDTH = 2 * D_MODEL
RET_V_DIM = RET_WIDTH // RET_HEADS
RET_CHUNK = 64
GLA_HEADS = 4
GLA_K_DIM = (D_MODEL // 2) // GLA_HEADS
GLA_WIDTH = D_MODEL
GLA_V_DIM = GLA_WIDTH // GLA_HEADS
GLA_GATE_RANK = 16
GLA_GATE_TAU = 16.0
GLA_CHUNK = 16
ROPE_BASE = 10000.0
EPS = 1e-6
IN_SIZES = (RET_HEADS * RET_QK_DIM, RET_HEADS * RET_QK_DIM, RET_WIDTH, RET_WIDTH,
            GLA_HEADS * GLA_K_DIM, GLA_HEADS * GLA_K_DIM, GLA_WIDTH, GLA_WIDTH,
            GLA_GATE_RANK, D_MODEL, D_MODEL)
IN_COLS = sum(IN_SIZES)

kernel_name = "hybrid_retention_gla_gated_merge"


def rms_norm(x, gain):
    xf = x.astype(jnp.float32)
    y = xf * lax.rsqrt(jnp.mean(xf * xf, axis=-1, keepdims=True) + EPS) * gain.astype(jnp.float32)
    return y.astype(x.dtype)


def head_group_norm(o, gain):
    of = o.astype(jnp.float32)
    mu = jnp.mean(of, axis=-1, keepdims=True)
    var = jnp.mean(jnp.square(of - mu), axis=-1, keepdims=True)
    return ((of - mu) * lax.rsqrt(var + EPS) * gain.astype(jnp.float32)).astype(o.dtype)


def head_rms_norm(o, gain):
    of = o.astype(jnp.float32)
    return (of * lax.rsqrt(jnp.mean(of * of, axis=-1, keepdims=True) + EPS) * gain.astype(jnp.float32)).astype(o.dtype)


def rope(t, pos):
    half = t.shape[-1] // 2
    inv = ROPE_BASE ** (-jnp.arange(half, dtype=jnp.float32) / half)
    ang = pos[:, None] * inv[None, :]
    cos = jnp.cos(ang)[None, :, None, :]
    sin = jnp.sin(ang)[None, :, None, :]
    t1 = t[..., :half].astype(jnp.float32)
    t2 = t[..., half:].astype(jnp.float32)
    return jnp.concatenate([t1 * cos - t2 * sin, t2 * cos + t1 * sin], axis=-1).astype(t.dtype)


def to_chunks(t, c):
    pad = (-N_META) % c
    t = jnp.pad(t, ((0, 0), (pad, 0), (0, 0), (0, 0)))
    b, lp, h, d = t.shape
    return t.reshape(b, lp // c, c, h, d)


def from_chunks(t, c):
    b, n, _, h, d = t.shape
    pad = (-N_META) % c
    return t.reshape(b, n * c, h, d)[:, pad:]


def retention_chunked(q, k, v):
    c = RET_CHUNK
    qc, kc, vc = to_chunks(q, c), to_chunks(k, c), to_chunks(v, c)
    log_gamma = jnp.log1p(-(2.0 ** (-5.0 - jnp.arange(RET_HEADS, dtype=jnp.float32))))
    idx = jnp.arange(c, dtype=jnp.float32)
    rel = idx[:, None] - idx[None, :]
    decay = jnp.where(rel[None] >= 0, jnp.exp(jnp.maximum(rel, 0.0)[None] * log_gamma[:, None, None]), 0.0)
    scores = jnp.einsum('bnihd,bnjhd->bnhij', qc, kc) * decay[None, None]
    intra = jnp.einsum('bnhij,bnjhe->bnihe', scores, vc)
    xi = jnp.exp((idx[:, None] + 1.0) * log_gamma[None, :])
    zeta = jnp.exp((c - 1.0 - idx[:, None]) * log_gamma[None, :])
    gamma_c = jnp.exp(c * log_gamma)

    def step(state, xs):
        q_n, k_n, v_n = xs
        inter = jnp.einsum('bihd,bhde->bihe', q_n, state) * xi[None, :, :, None]
        state = state * gamma_c[None, :, None, None] + jnp.einsum('bjhd,bjhe->bhde', k_n * zeta[None, :, :, None], v_n)
        return state, inter

    bsz = q.shape[0]
    state0 = jnp.zeros((bsz, RET_HEADS, RET_QK_DIM, RET_V_DIM), jnp.float32)
    xs = (jnp.moveaxis(qc, 1, 0), jnp.moveaxis(kc, 1, 0), jnp.moveaxis(vc, 1, 0))
    _, inter = lax.scan(step, state0, xs)
    out = intra + jnp.moveaxis(inter, 0, 1)
    return from_chunks(out, c).astype(v.dtype)


def gla_chunked(q, k, v, log_a):
    c = GLA_CHUNK
    qc, kc, vc = to_chunks(q, c), to_chunks(k, c), to_chunks(v, c)
    ac = to_chunks(log_a.astype(jnp.float32), c)
    b = jnp.cumsum(ac, axis=2)
    b_last = b[:, :, -1]
    q_dec = qc * jnp.exp(b)
    k_inv = kc * jnp.exp(-b)
    k_end = kc * jnp.exp(b_last[:, :, None] - b)
    mask = jnp.tril(jnp.ones((c, c), dtype=bool))
    scores = jnp.where(mask, jnp.einsum('bnihd,bnjhd->bnhij', q_dec, k_inv), 0.0)
    intra = jnp.einsum('bnhij,bnjhe->bnihe', scores, vc)

    def step(state, xs):
        q_n, k_n, v_n, a_n = xs
        inter = jnp.einsum('bihd,bhde->bihe', q_n, state)
        state = state * jnp.exp(a_n)[..., None] + jnp.einsum('bjhd,bjhe->bhde', k_n, v_n)
        return state, inter

    bsz = q.shape[0]
    state0 = jnp.zeros((bsz, GLA_HEADS, GLA_K_DIM, GLA_V_DIM), jnp.float32)
    xs = (jnp.moveaxis(q_dec, 1, 0), jnp.moveaxis(k_end, 1, 0), jnp.moveaxis(vc, 1, 0), jnp.moveaxis(b_last, 1, 0))
    _, inter = lax.scan(step, state0, xs)
    out = intra + jnp.moveaxis(inter, 0, 1)
    return from_chunks(out, c).astype(v.dtype)


def hybrid_layer(h, norm_gain, w_in, w_gate_up, b_gate, ret_norm_gain, gla_norm_gain,
                 w_branch_ret, w_branch_gla, w_out):
    bsz, length, _ = h.shape
    u = rms_norm(h, norm_gain)
    proj = u @ w_in
    points = [int(p) for p in np.cumsum(IN_SIZES)[:-1]]
    (rq, rk, rv, rg, gq, gk, gv, gg, glr, m_ret, m_gla) = jnp.split(proj, points, axis=-1)

    pos = jnp.arange(length, dtype=jnp.float32)
    rq = rope(rq.reshape(bsz, length, RET_HEADS, RET_QK_DIM), pos)
    rk = rope(rk.reshape(bsz, length, RET_HEADS, RET_QK_DIM), pos) * (RET_QK_DIM ** -0.5)
    rv = rv.reshape(bsz, length, RET_HEADS, RET_V_DIM)
    o_ret = retention_chunked(rq, rk, rv)
    o_ret = head_group_norm(o_ret, ret_norm_gain.reshape(RET_HEADS, RET_V_DIM)).reshape(bsz, length, RET_WIDTH)
    o_ret = o_ret * jax.nn.silu(rg)

    gq = gq.reshape(bsz, length, GLA_HEADS, GLA_K_DIM) * (GLA_K_DIM ** -0.5)
    gk = gk.reshape(bsz, length, GLA_HEADS, GLA_K_DIM)
    gv = gv.reshape(bsz, length, GLA_HEADS, GLA_V_DIM)
    log_a = jax.nn.log_sigmoid((glr @ w_gate_up + b_gate).astype(jnp.float32)) / GLA_GATE_TAU
    log_a = log_a.reshape(bsz, length, GLA_HEADS, GLA_K_DIM)
    o_gla = gla_chunked(gq, gk, gv, log_a)
    o_gla = head_rms_norm(o_gla, gla_norm_gain.reshape(GLA_HEADS, GLA_V_DIM)).reshape(bsz, length, GLA_WIDTH)
    o_gla = o_gla * jax.nn.silu(gg)

    merged = jax.nn.sigmoid(m_ret) * (o_ret @ w_branch_ret) + jax.nn.sigmoid(m_gla) * (o_gla @ w_branch_gla)
    return h + merged @ w_out


def setup_inputs(seed: int = 0) -> dict:
    key = jax.random.key(seed)
    ks = jax.random.split(key, 12)
    f = jnp.float32
    gk_dim = GLA_HEADS * GLA_K_DIM
    return {
        "x": jax.random.normal(ks[0], (BATCH, SEQ, D_MODEL), f),
        "meta_tokens": jax.random.normal(ks[1], (N_META, D_MODEL), f),
        "norm_gain": 1.0 + 0.02 * jax.random.normal(ks[2], (DEPTH, D_MODEL), f),
        "w_in": jax.random.normal(ks[3], (DEPTH, D_MODEL, IN_COLS), f) * D_MODEL ** -0.5,
        "w_gate_up": jax.random.normal(ks[4], (DEPTH, GLA_GATE_RANK, gk_dim), f) * GLA_GATE_RANK ** -0.5,
        "b_gate": 0.01 * jax.random.normal(ks[5], (DEPTH, gk_dim), f),
        "ret_norm_gain": 1.0 + 0.02 * jax.random.normal(ks[6], (DEPTH, RET_WIDTH), f),
        "gla_norm_gain": 1.0 + 0.02 * jax.random.normal(ks[7], (DEPTH, GLA_WIDTH), f),
        "w_branch_ret": jax.random.normal(ks[8], (DEPTH, RET_WIDTH, D_MODEL), f) * RET_WIDTH ** -0.5,
        "w_branch_gla": jax.random.normal(ks[9], (DEPTH, GLA_WIDTH, D_MODEL), f) * GLA_WIDTH ** -0.5,
        "w_out": jax.random.normal(ks[10], (DEPTH, D_MODEL, D_MODEL), f) * D_MODEL ** -0.5,
        "final_norm_gain": 1.0 + 0.02 * jax.random.normal(ks[11], (D_MODEL,), f),
    }


def reference(x, meta_tokens, norm_gain, w_in, w_gate_up, b_gate, ret_norm_gain, gla_norm_gain,
              w_branch_ret, w_branch_gla, w_out, final_norm_gain):
    bsz = x.shape[0]
    meta = jnp.broadcast_to(meta_tokens.astype(x.dtype)[None], (bsz, N_META, D_MODEL))
    h = jnp.concatenate([meta, x], axis=1)
    for layer in range(DEPTH):
        h = hybrid_layer(h, norm_gain[layer], w_in[layer], w_gate_up[layer], b_gate[layer],
                         ret_norm_gain[layer], gla_norm_gain[layer], w_branch_ret[layer],
                         w_branch_gla[layer], w_out[layer])
    h = rms_norm(h, final_norm_gain)
    return h[:, N_META:]
```

```cpp
#include <hip/hip_runtime.h>
#include <hip/hip_cooperative_groups.h>
#include <cstdio>
#include <cstdint>
namespace cg = cooperative_groups;

#ifndef MK_N_LAUNCHES
#define MK_N_LAUNCHES 1
#endif

#define LAS __attribute__((address_space(3)))
#define DI __device__ __forceinline__
typedef unsigned short bf16_t;
typedef short bf16x8 __attribute__((ext_vector_type(8)));
typedef short s16x4 __attribute__((ext_vector_type(4)));
typedef float f32x4 __attribute__((ext_vector_type(4)));
typedef float f32x2 __attribute__((ext_vector_type(2)));
typedef float f32x16 __attribute__((ext_vector_type(16)));
typedef unsigned u32x4 __attribute__((ext_vector_type(4)));
typedef unsigned u32x2 __attribute__((ext_vector_type(2)));
typedef __bf16 bf16x2_t __attribute__((ext_vector_type(2)));

constexpr int D = 1024, NB = 8, SEQ = 8192, NMETA = 16, LTOK = SEQ + NMETA;
constexpr int PADF = 48, LP = LTOK + PADF;
constexpr int ROWS = NB * LP;
constexpr int CROWS = NB * SEQ;
constexpr int IN_COLS = 11280;
constexpr int NCHUNK = LP / 64;
constexpr float EPS = 1e-6f;
constexpr int N1 = 8704, N1B = 3072;

constexpr size_t WS_CTL = 0;
constexpr size_t WS_STATS = 65536;
constexpr size_t WS_ROWSS = WS_STATS + (size_t)ROWS * 64;
constexpr size_t WS_ROPE = WS_ROWSS + (size_t)CROWS * 4;
constexpr size_t WS_BT1 = WS_ROPE + (size_t)LTOK * 128 * 8;
constexpr size_t WS_BT1B = WS_BT1 + (size_t)N1 * 1024 * 2;
constexpr size_t WS_BT3 = WS_BT1B + (size_t)N1B * 1024 * 2;
constexpr size_t WS_BT4 = WS_BT3 + (size_t)1024 * 3072 * 2;
constexpr size_t WS_U = WS_BT4 + (size_t)1024 * 1024 * 2;
constexpr size_t WS_RQ = WS_U + (size_t)ROWS * 2048;
constexpr size_t WS_RK = WS_RQ + (size_t)ROWS * 2048;
constexpr size_t WS_GQ = WS_RK + (size_t)ROWS * 2048;
constexpr size_t WS_GK = WS_GQ + (size_t)ROWS * 1024;
constexpr size_t WS_LA = WS_GK + (size_t)ROWS * 1024;
constexpr size_t WS_RV = WS_LA + (size_t)ROWS * 1024;
constexpr size_t WS_GV = WS_RV + (size_t)ROWS * 4096;
constexpr size_t WS_END = WS_GV + (size_t)ROWS * 2048;
static_assert(WS_END <= (size_t)1073741824, "workspace map exceeds 4x the largest tensor");
static_assert((size_t)CROWS * 3072 * 2 <= WS_RV - WS_RQ, "ACAT overlay");

constexpr int LDS_BYTES = 147456;

DI unsigned pk_bf16(float lo, float hi) { f32x2 v = {lo, hi}; bf16x2_t b = __builtin_convertvector(v, bf16x2_t); return __builtin_bit_cast(unsigned, b); }
DI float bf_lo(unsigned w) { return __uint_as_float(w << 16); }
DI float bf_hi(unsigned w) { return __uint_as_float(w & 0xffff0000u); }
DI float sigmoidf_(float x) { return __builtin_amdgcn_rcpf(1.0f + __expf(-x)); }

namespace pg8 {
constexpr int BM = 256, BK = 64, HALF = 128, HTB = HALF * BK * 2, STAGE_BYTES = 8 * HTB, NXCD = 8, WGM = 8;
__host__ __device__ __forceinline__ int lds_byte(int r, int c) { const int st = (r >> 4) * 2 + (c >> 5), rr = r & 15, cc = c & 31, ob = rr * 64 + cc * 2; return st * 1024 + (ob ^ (((ob >> 9) & 1) << 5)); }
__host__ __device__ __forceinline__ void stage_rc(int b, int& R, int& C) { const int st = b / 1024, sb = b % 1024, swz = sb ^ (((sb >> 9) & 1) << 5); R = (st >> 1) * 16 + swz / 64; C = (st & 1) * 32 + (swz % 64) / 2; }
__host__ __device__ __forceinline__ int perm32(int rho) { const int n = rho >> 4, i = rho & 15; return 8 * (i >> 2) + 4 * n + (i & 3); }

struct Unit { int pm, pn; };
struct Gemm { const bf16_t* A; const bf16_t* Bt; int M, N, K, amode; };
DI size_t a_row0(const Gemm& g, int pm) { return g.amode ? (size_t)((pm >> 5) * LP + 64 + (pm & 31) * 256) : (size_t)pm * 256; }

struct StaticOrder {
    int nM, nN, nwg, G, c;
    __host__ __device__ void init(int M, int N, int G_, int c_) { nM = M / BM; nN = N / BM; nwg = nM * nN; G = G_; c = c_; }
    __host__ __device__ bool next(int i, Unit& u) const {
        const long L = (long)i * G + c; if (L >= nwg) return false;
        int wgid = (int)L; { const int q = nwg / NXCD, r = nwg % NXCD, xcd = wgid % NXCD, off = wgid / NXCD; wgid = (xcd < r ? xcd * (q + 1) : r * (q + 1) + (xcd - r) * q) + off; }
        const int nig = WGM * nN, gid = wgid / nig, fm = gid * WGM, gsz = (nM - fm) < WGM ? (nM - fm) : WGM;
        u.pm = fm + ((wgid % nig) % gsz); u.pn = (wgid % nig) / gsz; return true;
    }
};

template <class Epi>
DI void gemm_phase(LAS unsigned char* lds, const Gemm g, const StaticOrder& S, const Epi& E, const int tid) {
    const int wid = __builtin_amdgcn_readfirstlane(tid >> 6), lane = tid & 63, wr = wid >> 2, wc = wid & 3, fr = lane & 15, fq = lane >> 4;
    const int K = g.K, nt = K / BK;
    unsigned voffA[2], voffB[2];
#pragma unroll
    for (int i = 0; i < 2; ++i) { int R, C; stage_rc(tid * 16 + i * 8192, R, C); const int Rb = Epi::PERM ? ((R & ~31) + perm32(R & 31)) : R;
        voffA[i] = (unsigned)(R * K + C) * 2u; voffB[i] = (unsigned)(Rb * K + C) * 2u; }
    const size_t kstep = (size_t)(BK * 2);
    const size_t hstep = (size_t)HALF * K * 2;
    const size_t tstep = 2 * hstep;
    const size_t rowb = (size_t)K * 2;
    const unsigned ldsw = (unsigned)wid * 1024u;
    const int aoff = lds_byte(wr * 64 + fr, fq * 8), boff = lds_byte(wc * 32 + fr, fq * 8);
#define PG8_SA(b, h) (((b) * 2 + (h)) * HTB)
#define PG8_SB(b, h) ((4 + (b) * 2 + (h)) * HTB)
#define PG8_STAGE(bufoff, gbase, voff) do { _Pragma("unroll") for (int _i = 0; _i < 2; ++_i) \
        __builtin_amdgcn_global_load_lds((const unsigned*)((const char*)(gbase) + (voff)[_i]), (LAS unsigned*)(lds + (bufoff) + ldsw + _i * 8192), 16, 0, 0); } while (0)
#define PG8_LDA(dst, b, h) do { _Pragma("unroll") for (int m = 0; m < 4; ++m) _Pragma("unroll") for (int k = 0; k < 2; ++k) dst[m][k] = *(const LAS bf16x8*)(lds + PG8_SA(b, h) + aoff + m * 2048 + k * 1024); } while (0)
#define PG8_LDB(dst, b, h) do { _Pragma("unroll") for (int n = 0; n < 2; ++n) _Pragma("unroll") for (int k = 0; k < 2; ++k) dst[n][k] = *(const LAS bf16x8*)(lds + PG8_SB(b, h) + boff + n * 2048 + k * 1024); } while (0)
#define PG8_MMA(ai, bj, At, Bt) do { __builtin_amdgcn_s_setprio(1); _Pragma("unroll") for (int m = 0; m < 4; ++m) _Pragma("unroll") for (int n = 0; n < 2; ++n) _Pragma("unroll") for (int k = 0; k < 2; ++k) \
        acc[ai][bj][m][n] = __builtin_amdgcn_mfma_f32_16x16x32_bf16(Bt[n][k], At[m][k], acc[ai][bj][m][n], 0, 0, 0); __builtin_amdgcn_s_setprio(0); } while (0)
#define PG8_WAIT_V(n) asm volatile("s_waitcnt vmcnt(" #n ")" ::: "memory")
#define PG8_WAIT_L(n) asm volatile("s_waitcnt lgkmcnt(" #n ")" ::: "memory")
#define PG8_BAR __builtin_amdgcn_s_barrier()
#define PG8_SCHED __builtin_amdgcn_sched_barrier(0)
    Unit cur, nxt; int ui = 0;
    if (!S.next(0, cur)) return;
    f32x4 acc[2][2][4][2];
#pragma unroll
    for (int a = 0; a < 2; ++a)
#pragma unroll
        for (int b = 0; b < 2; ++b)
#pragma unroll
            for (int m = 0; m < 4; ++m)
#pragma unroll
                for (int n = 0; n < 2; ++n) acc[a][b][m][n] = (f32x4){0.f, 0.f, 0.f, 0.f};
    bf16x8 At[4][2], B0[2][2], B1[2][2];
    const char* cA = (const char*)g.A + a_row0(g, cur.pm) * rowb; const char* cB = (const char*)g.Bt + (size_t)cur.pn * tstep;
    PG8_STAGE(PG8_SB(0, 0), cB, voffB); PG8_STAGE(PG8_SB(0, 1), cB + hstep, voffB); PG8_STAGE(PG8_SA(0, 0), cA, voffA); PG8_STAGE(PG8_SA(0, 1), cA + hstep, voffA);
    if (wr == 1) PG8_BAR;
    PG8_WAIT_V(2); PG8_BAR;
    PG8_STAGE(PG8_SB(1, 0), cB + kstep, voffB); PG8_STAGE(PG8_SA(1, 0), cA + kstep, voffA); PG8_STAGE(PG8_SB(1, 1), cB + hstep + kstep, voffB);
    PG8_WAIT_V(6); PG8_BAR;
    for (;;) {
        const bool has_next = S.next(ui + 1, nxt);
        const char* nA = has_next ? (const char*)g.A + a_row0(g, nxt.pm) * rowb : cA; const char* nB = has_next ? (const char*)g.Bt + (size_t)nxt.pn * tstep : cB;
        for (int t = 0; t < nt; t += 2) {
            if constexpr (Epi::MIDK >= 0) { if (t == Epi::MIDK) E.mid(acc, cur, wr, wc, fr, fq); }
            const bool last = (t == nt - 2);
            const char* a1 = cA + (size_t)(t + 1) * kstep;
            const char* a2 = last ? nA : cA + (size_t)(t + 2) * kstep; const char* b2 = last ? nB : cB + (size_t)(t + 2) * kstep;
            const char* a3 = a2 + kstep; const char* b3 = b2 + kstep;
            PG8_LDB(B0, 0, 0); PG8_LDB(B1, 0, 1); PG8_SCHED; PG8_LDA(At, 0, 0); PG8_STAGE(PG8_SA(1, 1), a1 + hstep, voffA);
            PG8_WAIT_V(8); PG8_WAIT_L(0); PG8_BAR; PG8_MMA(0, 0, At, B0); PG8_MMA(0, 1, At, B1); PG8_BAR; PG8_SCHED;
            PG8_LDA(At, 0, 1); PG8_STAGE(PG8_SB(0, 0), b2, voffB); PG8_STAGE(PG8_SB(0, 1), b2 + hstep, voffB); PG8_STAGE(PG8_SA(0, 0), a2, voffA);
            PG8_WAIT_V(8); PG8_WAIT_L(0); PG8_BAR; PG8_MMA(1, 0, At, B0); PG8_MMA(1, 1, At, B1); PG8_BAR; PG8_SCHED;
            PG8_LDB(B0, 1, 0); PG8_LDB(B1, 1, 1); PG8_SCHED; PG8_LDA(At, 1, 0); PG8_STAGE(PG8_SA(0, 1), a2 + hstep, voffA);
            PG8_WAIT_V(8); PG8_WAIT_L(0); PG8_BAR; PG8_MMA(0, 0, At, B0); PG8_MMA(0, 1, At, B1); PG8_BAR; PG8_SCHED;
            PG8_LDA(At, 1, 1); PG8_STAGE(PG8_SB(1, 0), b3, voffB); PG8_STAGE(PG8_SB(1, 1), b3 + hstep, voffB); PG8_STAGE(PG8_SA(1, 0), a3, voffA);
            PG8_WAIT_V(8); PG8_WAIT_L(0); PG8_BAR; PG8_MMA(1, 0, At, B0); PG8_MMA(1, 1, At, B1); PG8_BAR; PG8_SCHED;
        }
        if (wr == 0) PG8_BAR;
        E(acc, cur, wr, wc, fr, fq);
        if (!has_next) break;
#pragma unroll
        for (int a = 0; a < 2; ++a)
#pragma unroll
            for (int b = 0; b < 2; ++b)
#pragma unroll
                for (int m = 0; m < 4; ++m)
#pragma unroll
                    for (int n = 0; n < 2; ++n) acc[a][b][m][n] = (f32x4){0.f, 0.f, 0.f, 0.f};
        cur = nxt; cA = nA; cB = nB; ++ui;
        if (wr == 1) PG8_BAR;
    }
    PG8_WAIT_V(0);
    PG8_BAR;
#undef PG8_SA
#undef PG8_SB
#undef PG8_STAGE
#undef PG8_LDA
#undef PG8_LDB
#undef PG8_MMA
#undef PG8_WAIT_V
#undef PG8_WAIT_L
#undef PG8_BAR
#undef PG8_SCHED
}
}

typedef f32x4 Acc[2][2][4][2];

struct EpiProj {
    static constexpr bool PERM = true; static constexpr int MIDK = -1;
    unsigned char* ws; bf16_t* srg; const float* b_gate;
    template <int MODE> DI void run(const Acc& acc, int row0, int cl, bf16_t* base, int pitch, int colt, int head) const {
        const f32x2* rope = (const f32x2*)(ws + WS_ROPE);
        const float lg2 = __log2f(1.0f - exp2f(-5.0f - (float)head));
#pragma unroll
        for (int ai = 0; ai < 2; ++ai)
#pragma unroll
            for (int m = 0; m < 4; ++m) {
                const int row = row0 + ai * 128 + m * 16;
                const int b = row / LP, p = row - b * LP;
                if (MODE == 2) {
                    if (p < 64) continue;
                    bf16_t* rowp = base + (size_t)(b * SEQ + p - 64) * pitch + colt + cl;
#pragma unroll
                    for (int bj = 0; bj < 2; ++bj) { const f32x4 v0 = acc[ai][bj][m][0], v1 = acc[ai][bj][m][1]; u32x4 w;
                        w.x = pk_bf16(sigmoidf_(v0[0]), sigmoidf_(v0[1])); w.y = pk_bf16(sigmoidf_(v0[2]), sigmoidf_(v0[3]));
                        w.z = pk_bf16(sigmoidf_(v1[0]), sigmoidf_(v1[1])); w.w = pk_bf16(sigmoidf_(v1[2]), sigmoidf_(v1[3]));
                        *(u32x4*)(rowp + bj * 128) = w; }
                } else if (MODE == 4 || MODE == 5) {
                    bf16_t* rowp = base + (size_t)row * pitch + colt + cl;
                    const int t = p >= PADF ? p - PADF : 0;
                    const f32x4* rp = (const f32x4*)(rope + (size_t)t * 128 + cl);
                    const f32x4 r0 = rp[0], r1 = rp[1], r2 = rp[2], r3 = rp[3];
                    const float ic = (float)(p & 63);
                    const float sc = MODE == 4 ? exp2f(ic * lg2) : 0.0625f * exp2f(-ic * lg2);
                    const f32x4 a0 = acc[ai][0][m][0], a1 = acc[ai][0][m][1], c0 = acc[ai][1][m][0], c1 = acc[ai][1][m][1];
                    float o1[8], o2[8];
                    const float cs[8] = {r0[0], r0[2], r1[0], r1[2], r2[0], r2[2], r3[0], r3[2]};
                    const float sn[8] = {r0[1], r0[3], r1[1], r1[3], r2[1], r2[3], r3[1], r3[3]};
                    const float t1[8] = {a0[0], a0[1], a0[2], a0[3], a1[0], a1[1], a1[2], a1[3]};
                    const float t2[8] = {c0[0], c0[1], c0[2], c0[3], c1[0], c1[1], c1[2], c1[3]};
#pragma unroll
                    for (int j = 0; j < 8; ++j) { o1[j] = (t1[j] * cs[j] - t2[j] * sn[j]) * sc; o2[j] = (t2[j] * cs[j] + t1[j] * sn[j]) * sc; }
                    u32x4 w1, w2;
                    w1.x = pk_bf16(o1[0], o1[1]); w1.y = pk_bf16(o1[2], o1[3]); w1.z = pk_bf16(o1[4], o1[5]); w1.w = pk_bf16(o1[6], o1[7]);
                    w2.x = pk_bf16(o2[0], o2[1]); w2.y = pk_bf16(o2[2], o2[3]); w2.z = pk_bf16(o2[4], o2[5]); w2.w = pk_bf16(o2[6], o2[7]);
                    *(u32x4*)(rowp) = w1; *(u32x4*)(rowp + 128) = w2;
                } else {
                    bf16_t* rowp = base + (size_t)row * pitch + colt + cl;
#pragma unroll
                    for (int bj = 0; bj < 2; ++bj) { f32x4 v0 = acc[ai][bj][m][0], v1 = acc[ai][bj][m][1];
                        if (MODE == 1) { v0 = v0 * 0.08838834764831845f; v1 = v1 * 0.08838834764831845f; }
                        if (MODE == 3) {
                            const f32x4 g0 = *(const f32x4*)(b_gate + colt + cl + bj * 128), g1 = *(const f32x4*)(b_gate + colt + cl + bj * 128 + 4);
                            v0 = v0 + g0; v1 = v1 + g1;
#pragma unroll
                            for (int j = 0; j < 4; ++j) { v0[j] = -0.0625f * (fmaxf(-v0[j], 0.f) + __logf(1.0f + __expf(-fabsf(v0[j])))); v1[j] = -0.0625f * (fmaxf(-v1[j], 0.f) + __logf(1.0f + __expf(-fabsf(v1[j])))); }
                        }
                        u32x4 w; w.x = pk_bf16(v0[0], v0[1]); w.y = pk_bf16(v0[2], v0[3]); w.z = pk_bf16(v1[0], v1[1]); w.w = pk_bf16(v1[2], v1[3]);
                        *(u32x4*)(rowp + bj * 128) = w; }
                }
            }
    }
    DI void operator()(const Acc& acc, const pg8::Unit& u, int wr, int wc, int fr, int fq) const {
        asm volatile("" : "+v"(fr), "+v"(fq));
        const int row0 = u.pm * 256 + wr * 64 + fr, cl = wc * 32 + 8 * fq, pn = u.pn;
        if (pn < 4)       run<4>(acc, row0, cl, (bf16_t*)(ws + WS_RQ), 1024, 256 * pn, pn);
        else if (pn < 8)  run<5>(acc, row0, cl, (bf16_t*)(ws + WS_RK), 1024, 256 * (pn - 4), pn - 4);
        else if (pn < 16) run<0>(acc, row0, cl, (bf16_t*)(ws + WS_RV), 2048, 256 * (pn - 8), 0);
        else if (pn < 18) run<1>(acc, row0, cl, (bf16_t*)(ws + WS_GQ), 512, 256 * (pn - 16), 0);
        else if (pn < 20) run<0>(acc, row0, cl, (bf16_t*)(ws + WS_GK), 512, 256 * (pn - 18), 0);
        else if (pn < 24) run<0>(acc, row0, cl, (bf16_t*)(ws + WS_GV), 1024, 256 * (pn - 20), 0);
        else if (pn < 32) run<2>(acc, row0, cl, srg, 2048, 256 * (pn - 24), 0);
        else              run<3>(acc, row0, cl, (bf16_t*)(ws + WS_LA), 512, 256 * (pn - 32), 0);
    }
};

struct EpiGate {
    static constexpr bool PERM = true; static constexpr int MIDK = -1;
    unsigned char* ws; const float* ret_gain; const float* gla_gain;
    DI void operator()(const Acc& acc, const pg8::Unit& u, int wr, int wc, int fr, int fq) const {
        asm volatile("" : "+v"(fr), "+v"(fq));
        const int pn = u.pn, pm = u.pm, cl = wc * 32 + 8 * fq;
        const bool ret = pn < 8;
        const int col0 = ret ? 256 * pn : 256 * (pn - 8);
        const int slot = ret ? (pn >> 1) : 4 + (pn - 8);
        const bf16_t* O = (const bf16_t*)(ws + (ret ? WS_RV : WS_GV)); const int opitch = ret ? 2048 : 1024;
        const float* gain = (ret ? ret_gain : gla_gain) + col0 + cl;
        const float invn = ret ? (1.0f / 512.0f) : (1.0f / 256.0f);
        const float* stats = (const float*)(ws + WS_STATS);
        bf16_t* acat = (bf16_t*)(ws + WS_RQ);
        const int acol = (ret ? 0 : 2048) + col0 + cl;
        const size_t prow0 = (size_t)((pm >> 5) * LP + 64 + (pm & 31) * 256), crow0 = (size_t)pm * 256;
        f32x4 gn[2][2];
#pragma unroll
        for (int bj = 0; bj < 2; ++bj) { gn[bj][0] = *(const f32x4*)(gain + bj * 128); gn[bj][1] = *(const f32x4*)(gain + bj * 128 + 4); }
#pragma unroll
        for (int ai = 0; ai < 2; ++ai)
#pragma unroll
            for (int m = 0; m < 4; ++m) {
                const int rr = ai * 128 + wr * 64 + m * 16 + fr;
                const f32x2 st = *(const f32x2*)(stats + (prow0 + rr) * 16 + slot * 2);
                const float mu = ret ? st.x * invn : 0.f;
                const float var = st.y * invn - mu * mu;
                const float rs = __builtin_amdgcn_rsqf(fmaxf(var, 0.f) + EPS);
                const bf16_t* orow = O + (prow0 + rr) * opitch + col0 + cl;
                bf16_t* arow = acat + (crow0 + rr) * 3072 + acol;
#pragma unroll
                for (int bj = 0; bj < 2; ++bj) {
                    const u32x4 ov = *(const u32x4*)(orow + bj * 128);
                    const f32x4 v0 = acc[ai][bj][m][0], v1 = acc[ai][bj][m][1];
                    const float o[8] = {bf_lo(ov.x), bf_hi(ov.x), bf_lo(ov.y), bf_hi(ov.y), bf_lo(ov.z), bf_hi(ov.z), bf_lo(ov.w), bf_hi(ov.w)};
                    const float gt[8] = {v0[0], v0[1], v0[2], v0[3], v1[0], v1[1], v1[2], v1[3]};
                    const float gg[8] = {gn[bj][0][0], gn[bj][0][1], gn[bj][0][2], gn[bj][0][3], gn[bj][1][0], gn[bj][1][1], gn[bj][1][2], gn[bj][1][3]};
                    float r[8];
#pragma unroll
                    for (int j = 0; j < 8; ++j) r[j] = (o[j] - mu) * rs * gg[j] * (gt[j] * sigmoidf_(gt[j]));
                    u32x4 w; w.x = pk_bf16(r[0], r[1]); w.y = pk_bf16(r[2], r[3]); w.z = pk_bf16(r[4], r[5]); w.w = pk_bf16(r[6], r[7]);
                    *(u32x4*)(arow + bj * 128) = w;
                }
                asm volatile("" ::: "memory");
            }
    }
};

struct EpiMerge {
    static constexpr bool PERM = true; static constexpr int MIDK = 32;
    const bf16_t* srg; bf16_t* merged;
    DI void mid(Acc& acc, const pg8::Unit& u, int wr, int wc, int fr, int fq) const {
        asm volatile("" : "+v"(fr), "+v"(fq));
        const int col = 256 * u.pn + wc * 32 + 8 * fq;
#pragma unroll
        for (int ai = 0; ai < 2; ++ai)
#pragma unroll
            for (int m = 0; m < 4; ++m) {
                const size_t row = (size_t)u.pm * 256 + ai * 128 + wr * 64 + m * 16 + fr;
#pragma unroll
                for (int bj = 0; bj < 2; ++bj) {
                    const u32x4 sv = *(const u32x4*)(srg + row * 2048 + col + bj * 128);
                    const u32x4 gv = *(const u32x4*)(srg + row * 2048 + 1024 + col + bj * 128);
                    f32x4 r0 = {bf_lo(sv.x) * __builtin_amdgcn_rcpf(bf_lo(gv.x)), bf_hi(sv.x) * __builtin_amdgcn_rcpf(bf_hi(gv.x)), bf_lo(sv.y) * __builtin_amdgcn_rcpf(bf_lo(gv.y)), bf_hi(sv.y) * __builtin_amdgcn_rcpf(bf_hi(gv.y))};
                    f32x4 r1 = {bf_lo(sv.z) * __builtin_amdgcn_rcpf(bf_lo(gv.z)), bf_hi(sv.z) * __builtin_amdgcn_rcpf(bf_hi(gv.z)), bf_lo(sv.w) * __builtin_amdgcn_rcpf(bf_lo(gv.w)), bf_hi(sv.w) * __builtin_amdgcn_rcpf(bf_hi(gv.w))};
                    acc[ai][bj][m][0] = acc[ai][bj][m][0] * r0; acc[ai][bj][m][1] = acc[ai][bj][m][1] * r1;
                }
                asm volatile("" ::: "memory");
            }
    }
    DI void operator()(const Acc& acc, const pg8::Unit& u, int wr, int wc, int fr, int fq) const {
        asm volatile("" : "+v"(fr), "+v"(fq));
        const int col = 256 * u.pn + wc * 32 + 8 * fq;
#pragma unroll
        for (int ai = 0; ai < 2; ++ai)
#pragma unroll
            for (int m = 0; m < 4; ++m) {
                const size_t row = (size_t)u.pm * 256 + ai * 128 + wr * 64 + m * 16 + fr;
#pragma unroll
                for (int bj = 0; bj < 2; ++bj) {
                    const u32x4 gv = *(const u32x4*)(srg + row * 2048 + 1024 + col + bj * 128);
                    const f32x4 v0 = acc[ai][bj][m][0], v1 = acc[ai][bj][m][1];
                    u32x4 w; w.x = pk_bf16(v0[0] * bf_lo(gv.x), v0[1] * bf_hi(gv.x)); w.y = pk_bf16(v0[2] * bf_lo(gv.y), v0[3] * bf_hi(gv.y));
                    w.z = pk_bf16(v1[0] * bf_lo(gv.z), v1[1] * bf_hi(gv.z)); w.w = pk_bf16(v1[2] * bf_lo(gv.w), v1[3] * bf_hi(gv.w));
                    *(u32x4*)(merged + row * 1024 + col + bj * 128) = w;
                }
                asm volatile("" ::: "memory");
            }
    }
};

struct EpiOut {
    static constexpr bool PERM = false; static constexpr int MIDK = -1;
    const float* x; float* y; float* rowss;
    DI void operator()(const Acc& acc, const pg8::Unit& u, int wr, int wc, int fr, int fq) const {
        asm volatile("" : "+v"(fr), "+v"(fq));
        const int col = 256 * u.pn + wc * 32 + 4 * fq;
#pragma unroll
        for (int ai = 0; ai < 2; ++ai)
#pragma unroll
            for (int m = 0; m < 4; ++m) {
                const size_t row = (size_t)u.pm * 256 + ai * 128 + wr * 64 + m * 16 + fr;
                float ss = 0.f;
#pragma unroll
                for (int bj = 0; bj < 2; ++bj)
#pragma unroll
                    for (int n = 0; n < 2; ++n) {
                        const size_t o = row * 1024 + col + bj * 128 + n * 16;
                        const f32x4 v = *(const f32x4*)(x + o) + acc[ai][bj][m][n];
                        ss += (v[0] * v[0] + v[1] * v[1]) + (v[2] * v[2] + v[3] * v[3]);
                        *(f32x4*)(y + o) = v;
                    }
                ss += __shfl_xor(ss, 16); ss += __shfl_xor(ss, 32);
                if (fq == 0) atomicAdd(rowss + row, ss);
            }
    }
};

DI unsigned img_off(unsigned row, unsigned ch) {
    return ((ch >> 4) * 64u + row) * 256u + 16u * ((ch & 15u) ^ (((row & 3u) << 2) | ((row >> 2) & 3u)));
}
DI s16x4 tr4(const LAS unsigned char* p) { return __builtin_bit_cast(s16x4, __builtin_amdgcn_ds_read_tr16_b64_v4i16((LAS s16x4*)p)); }
DI bf16x8 tr_frag(const LAS unsigned char* base, int ks, int c, int lane) {
    const unsigned h = lane >> 5, blk = (lane >> 4) & 1, q = (lane & 15) >> 2, p = lane & 3;
    const unsigned ch = 4 * c + 2 * blk + (p >> 1), r0 = 16 * ks + 8 * h + q;
    const s16x4 lo = tr4(base + img_off(r0, ch) + 8 * (p & 1));
    const s16x4 hi = tr4(base + img_off(r0 + 4, ch) + 8 * (p & 1));
    return __builtin_shufflevector(lo, hi, 0, 1, 2, 3, 4, 5, 6, 7);
}
DI bf16x8 pack8(const f32x16& x, int s) {
    u32x4 p; p.x = pk_bf16(x[8 * s], x[8 * s + 1]); p.y = pk_bf16(x[8 * s + 2], x[8 * s + 3]); p.z = pk_bf16(x[8 * s + 4], x[8 * s + 5]); p.w = pk_bf16(x[8 * s + 6], x[8 * s + 7]);
    return __builtin_bit_cast(bf16x8, p);
}
#define MFMA32(a, b, c) __builtin_amdgcn_mfma_f32_32x32x16_bf16((a), (b), (c), 0, 0, 0)

template <int DK, bool GLA>
DI void scan_unit(LAS unsigned char* lds, const bf16_t* Qg, const bf16_t* Kg, bf16_t* Vg, const bf16_t* LAg, float* statp, int qkp, int vp, float g64, const int tid) {
    constexpr int NT = DK / 64;
    constexpr int NQ = DK / 64;
    constexpr int CPR = DK / 8;
    constexpr int QS = 0, KS = QS + 64 * DK * 2, VS = KS + 64 * DK * 2, PS = VS + 16384, XS = PS + 64 * 144, OS = XS + 32768, LAF = OS + 64 * 272, QT = LAF + 64 * 132 * 4, GS = QT + 4 * 128 * 4, END = GLA ? GS + 512 : LAF;
    static_assert(END <= LDS_BYTES, "scan LDS map");
    const int lane0 = tid & 63, v = __builtin_amdgcn_readfirstlane(tid >> 6), et = v & 3, kh = v >> 2;
    f32x16 S[NT];
#pragma unroll
    for (int kt = 0; kt < NT; ++kt)
#pragma unroll
        for (int i = 0; i < 16; ++i) S[kt][i] = 0.f;
    u32x4 qreg[NQ], kreg[NQ], vreg[2], lreg[2];
    auto load_chunk = [&](int n) {
        const size_t row0 = (size_t)n * 64;
#pragma unroll
        for (int i = 0; i < NQ; ++i) { const int pi = tid + 512 * i, row = pi / CPR, ch = pi % CPR;
            qreg[i] = *(const u32x4*)(Qg + (row0 + row) * qkp + ch * 8); kreg[i] = *(const u32x4*)(Kg + (row0 + row) * qkp + ch * 8);
            if (GLA) lreg[i] = *(const u32x4*)(LAg + (row0 + row) * qkp + ch * 8); }
#pragma unroll
        for (int i = 0; i < 2; ++i) { const int pi = tid + 512 * i, row = pi >> 4, ch = pi & 15; vreg[i] = *(const u32x4*)(Vg + (row0 + row) * vp + ch * 8); }
    };
    load_chunk(0);
    for (int n = 0; n < NCHUNK; ++n) {
        int lane = lane0; asm volatile("" : "+v"(lane));
        const int r = lane & 31, h = lane >> 5;
        if (GLA) {
#pragma unroll
            for (int i = 0; i < 2; ++i) { const int pi = tid + 512 * i, row = pi >> 4, ch = pi & 15;
                const bool pad = (n == 0) && (row < PADF);
                const u32x4 w = lreg[i];
                f32x4 a = {bf_lo(w.x), bf_hi(w.x), bf_lo(w.y), bf_hi(w.y)}, b = {bf_lo(w.z), bf_hi(w.z), bf_lo(w.w), bf_hi(w.w)};
                if (pad) { a = (f32x4){0.f, 0.f, 0.f, 0.f}; b = a; }
                LAS float* d = (LAS float*)(lds + LAF) + row * 132 + ch * 8;
                *(LAS f32x4*)d = a; *(LAS f32x4*)(d + 4) = b; }
            __syncthreads();
            { const int c = tid & 127, qd = tid >> 7; LAS float* col = (LAS float*)(lds + LAF) + c + qd * 16 * 132; float s = 0.f;
#pragma unroll
              for (int i = 0; i < 16; ++i) { s += col[i * 132]; col[i * 132] = s; }
              ((LAS float*)(lds + QT))[qd * 128 + c] = s; }
            __syncthreads();
#pragma unroll
            for (int i = 0; i < 2; ++i) { const int pi = tid + 512 * i, row = pi >> 4, ch = pi & 15, qd = row >> 4;
                const LAS float* d = (const LAS float*)(lds + LAF) + row * 132 + ch * 8;
                f32x4 b0 = *(const LAS f32x4*)d, b1 = *(const LAS f32x4*)(d + 4);
#pragma unroll
                for (int q = 0; q < 3; ++q) if (q < qd) { const LAS float* t = (const LAS float*)(lds + QT) + q * 128 + ch * 8; b0 = b0 + *(const LAS f32x4*)t; b1 = b1 + *(const LAS f32x4*)(t + 4); }
                float e[8], ei[8];
#pragma unroll
                for (int j = 0; j < 4; ++j) { e[j] = __expf(b0[j]); e[4 + j] = __expf(b1[j]); }
#pragma unroll
                for (int j = 0; j < 8; ++j) ei[j] = __builtin_amdgcn_rcpf(e[j]);
                const u32x4 qw = qreg[i], kw = kreg[i]; u32x4 qo, ko;
                qo.x = pk_bf16(bf_lo(qw.x) * e[0], bf_hi(qw.x) * e[1]); qo.y = pk_bf16(bf_lo(qw.y) * e[2], bf_hi(qw.y) * e[3]); qo.z = pk_bf16(bf_lo(qw.z) * e[4], bf_hi(qw.z) * e[5]); qo.w = pk_bf16(bf_lo(qw.w) * e[6], bf_hi(qw.w) * e[7]);
                ko.x = pk_bf16(bf_lo(kw.x) * ei[0], bf_hi(kw.x) * ei[1]); ko.y = pk_bf16(bf_lo(kw.y) * ei[2], bf_hi(kw.y) * ei[3]); ko.z = pk_bf16(bf_lo(kw.z) * ei[4], bf_hi(kw.z) * ei[5]); ko.w = pk_bf16(bf_lo(kw.w) * ei[6], bf_hi(kw.w) * ei[7]);
                *(LAS u32x4*)(lds + QS + img_off(row, ch)) = qo; *(LAS u32x4*)(lds + KS + img_off(row, ch)) = ko;
                if (row == 63) { LAS float* gp = (LAS float*)(lds + GS) + ch * 8; *(LAS f32x4*)gp = (f32x4){e[0], e[1], e[2], e[3]}; *(LAS f32x4*)(gp + 4) = (f32x4){e[4], e[5], e[6], e[7]}; } }
        } else {
#pragma unroll
            for (int i = 0; i < NQ; ++i) { const int pi = tid + 512 * i, row = pi / CPR, ch = pi % CPR;
                *(LAS u32x4*)(lds + QS + img_off(row, ch)) = qreg[i]; *(LAS u32x4*)(lds + KS + img_off(row, ch)) = kreg[i]; }
        }
#pragma unroll
        for (int i = 0; i < 2; ++i) { const int pi = tid + 512 * i, row = pi >> 4, ch = pi & 15; *(LAS u32x4*)(lds + VS + img_off(row, ch)) = vreg[i]; }
        __syncthreads();
        if (n + 1 < NCHUNK) load_chunk(n + 1);
        if (v < 3) {
            const int jt = v >> 1, it = (v + 1) >> 1;
            f32x16 p;
#pragma unroll
            for (int i = 0; i < 16; ++i) p[i] = 0.f;
#pragma unroll 4
            for (int s = 0; s < DK / 16; ++s) {
                const bf16x8 a = *(const LAS bf16x8*)(lds + KS + img_off(32 * jt + r, 2 * s + h));
                const bf16x8 b = *(const LAS bf16x8*)(lds + QS + img_off(32 * it + r, 2 * s + h));
                p = MFMA32(a, b, p);
            }
            const bool diag = (jt == it);
#pragma unroll
            for (int g = 0; g < 4; ++g) {
                float x[4];
#pragma unroll
                for (int j = 0; j < 4; ++j) { const int jl = 8 * g + 4 * h + j; x[j] = (!diag || r >= jl) ? p[4 * g + j] : 0.f; }
                u32x2 w; w.x = pk_bf16(x[0], x[1]); w.y = pk_bf16(x[2], x[3]);
                *(LAS u32x2*)(lds + PS + (32 * it + r) * 144 + (32 * jt + 8 * g + 4 * h) * 2) = w;
            }
        }
        f32x16 o0, o1;
#pragma unroll
        for (int i = 0; i < 16; ++i) { o0[i] = 0.f; o1[i] = 0.f; }
#pragma unroll
        for (int kt = 0; kt < NT; ++kt) {
#pragma unroll
            for (int s = 0; s < 2; ++s) {
                const bf16x8 xs = pack8(S[kt], s);
                const unsigned ch0 = (unsigned)(kh * (DK / 2) + 32 * kt + 16 * s) >> 3;
                const s16x4 a0l = *(const LAS s16x4*)(lds + QS + img_off(r, ch0) + 8 * h), a0h = *(const LAS s16x4*)(lds + QS + img_off(r, ch0 + 1) + 8 * h);
                const s16x4 a1l = *(const LAS s16x4*)(lds + QS + img_off(32 + r, ch0) + 8 * h), a1h = *(const LAS s16x4*)(lds + QS + img_off(32 + r, ch0 + 1) + 8 * h);
                o0 = MFMA32(__builtin_shufflevector(a0l, a0h, 0, 1, 2, 3, 4, 5, 6, 7), xs, o0);
                o1 = MFMA32(__builtin_shufflevector(a1l, a1h, 0, 1, 2, 3, 4, 5, 6, 7), xs, o1);
            }
        }
        f32x16 keep, send;
#pragma unroll
        for (int i = 0; i < 16; ++i) { keep[i] = kh ? o1[i] : o0[i]; send[i] = kh ? o0[i] : o1[i]; }
        { LAS f32x4* xp = (LAS f32x4*)(lds + XS + v * 4096) + lane;
#pragma unroll
          for (int g = 0; g < 4; ++g) xp[g * 64] = (f32x4){send[4 * g], send[4 * g + 1], send[4 * g + 2], send[4 * g + 3]}; }
        __syncthreads();
        { const LAS f32x4* xp = (const LAS f32x4*)(lds + XS + (v ^ 4) * 4096) + lane;
#pragma unroll
          for (int g = 0; g < 4; ++g) { const f32x4 t = xp[g * 64]; keep[4 * g] += t[0]; keep[4 * g + 1] += t[1]; keep[4 * g + 2] += t[2]; keep[4 * g + 3] += t[3]; } }
        bf16x8 vb[4];
#pragma unroll
        for (int ks = 0; ks < 4; ++ks) vb[ks] = tr_frag(lds + VS, ks, et, lane);
#pragma unroll
        for (int s = 0; s < 4; ++s) if (s < 2 * (kh + 1)) {
            const bf16x8 a = *(const LAS bf16x8*)(lds + PS + (32 * kh + r) * 144 + (16 * s + 8 * h) * 2);
            keep = MFMA32(a, vb[s], keep);
        }
        { LAS bf16_t* op = (LAS bf16_t*)(lds + OS);
#pragma unroll
          for (int i = 0; i < 16; ++i) { const int row = 32 * kh + (i & 3) + 8 * (i >> 2) + 4 * h; op[row * 136 + 32 * et + r] = (bf16_t)(pk_bf16(keep[i], 0.f) & 0xffffu); } }
#pragma unroll
        for (int kt = 0; kt < NT; ++kt) {
            const int c = (kh * (DK / 2) + 32 * kt) >> 5;
#pragma unroll
            for (int ks = 0; ks < 4; ++ks) { const bf16x8 a = tr_frag(lds + KS, ks, c, lane); S[kt] = MFMA32(a, vb[ks], S[kt]); }
            if (GLA) {
                const LAS float* gp = (const LAS float*)(lds + GS) + kh * (DK / 2) + 32 * kt + 4 * h;
#pragma unroll
                for (int g = 0; g < 4; ++g) { const f32x4 gv = *(const LAS f32x4*)(gp + 8 * g); S[kt][4 * g] *= gv[0]; S[kt][4 * g + 1] *= gv[1]; S[kt][4 * g + 2] *= gv[2]; S[kt][4 * g + 3] *= gv[3]; }
            } else {
#pragma unroll
                for (int i = 0; i < 16; ++i) S[kt][i] *= g64;
            }
        }
        __syncthreads();
        { const int row = tid >> 3, seg = tid & 7;
          const LAS u32x4* op = (const LAS u32x4*)(lds + OS + row * 272 + seg * 32);
          const u32x4 w0 = op[0], w1 = op[1];
          const float x[16] = {bf_lo(w0.x), bf_hi(w0.x), bf_lo(w0.y), bf_hi(w0.y), bf_lo(w0.z), bf_hi(w0.z), bf_lo(w0.w), bf_hi(w0.w), bf_lo(w1.x), bf_hi(w1.x), bf_lo(w1.y), bf_hi(w1.y), bf_lo(w1.z), bf_hi(w1.z), bf_lo(w1.w), bf_hi(w1.w)};
          float s = 0.f, ss = 0.f;
#pragma unroll
          for (int j = 0; j < 16; ++j) { s += x[j]; ss += x[j] * x[j]; }
          s += __shfl_xor(s, 1); ss += __shfl_xor(ss, 1); s += __shfl_xor(s, 2); ss += __shfl_xor(ss, 2); s += __shfl_xor(s, 4); ss += __shfl_xor(ss, 4);
          const size_t grow = (size_t)n * 64 + row;
          if (seg == 0) { atomicAdd(statp + grow * 16, s); atomicAdd(statp + grow * 16 + 1, ss); }
          u32x4* gp = (u32x4*)(Vg + grow * vp + seg * 16); gp[0] = w0; gp[1] = w1; }
    }
    __syncthreads();
}

struct Args { const float* in[12]; float* out; unsigned char* ws; int ph_lo, ph_hi; };

DI float wave_sum(float v) {
#pragma unroll
    for (int o = 1; o < 64; o <<= 1) v += __shfl_xor(v, o);
    return v;
}
DI void transpose_item(const float* W, int N, bf16_t* WT, int dpitch, int koff, int k0, int scol0, int drow0, LAS float* scr, int lane) {
#pragma unroll 8
    for (int i = 0; i < 32; ++i) { const int kk = 2 * i + (lane >> 5); scr[kk * 33 + (lane & 31)] = W[(size_t)(k0 + kk) * N + scol0 + (lane & 31)]; }
    asm volatile("s_waitcnt lgkmcnt(0)" ::: "memory");
    const int c = lane & 7;
#pragma unroll
    for (int j = 0; j < 4; ++j) { const int n = (lane >> 3) + 8 * j; const LAS float* s = scr + (8 * c) * 33 + n;
        u32x4 o; o.x = pk_bf16(s[0 * 33], s[1 * 33]); o.y = pk_bf16(s[2 * 33], s[3 * 33]); o.z = pk_bf16(s[4 * 33], s[5 * 33]); o.w = pk_bf16(s[6 * 33], s[7 * 33]);
        *(u32x4*)(WT + (size_t)(drow0 + n) * dpitch + koff + k0 + 8 * c) = o; }
    asm volatile("s_waitcnt lgkmcnt(0)" ::: "memory");
}

__global__ void __launch_bounds__(512, 2) mk_fwd(Args a) {
    extern __shared__ __attribute__((aligned(16))) unsigned char lds_raw[];
    LAS unsigned char* lds = (LAS unsigned char*)lds_raw;
    unsigned char* ws = a.ws;
    const float* x = a.in[0]; const float* meta = a.in[1]; const float* norm_gain = a.in[2]; const float* w_in = a.in[3];
    const float* w_gate_up = a.in[4]; const float* b_gate = a.in[5]; const float* ret_gain = a.in[6]; const float* gla_gain = a.in[7];
    const float* w_br = a.in[8]; const float* w_bg = a.in[9]; const float* w_out = a.in[10]; const float* fgain = a.in[11];
    bf16_t* srg = (bf16_t*)a.out;
#if MK_N_LAUNCHES == 1
#define GRID_SYNC() cg::this_grid().sync()
#else
#define GRID_SYNC() do {} while (0)
#endif
#define PH_BEGIN(k) if (a.ph_lo <= (k) && (k) < a.ph_hi) { \
        int bxo = blockIdx.x, Go = gridDim.x, tid = threadIdx.x; asm volatile("" : "+s"(bxo), "+s"(Go), "+v"(tid)); \
        const int lane = tid & 63, wave = __builtin_amdgcn_readfirstlane(tid >> 6), G = Go, bx = bxo; \
        const int vcu = (G % 8 == 0) ? (bx % 8) * (G / 8) + bx / 8 : bx; (void)lane; (void)wave; (void)vcu;
#define PH_END(k) if ((k) + 1 < a.ph_hi) GRID_SYNC(); }
    {
        PH_BEGIN(0)
            const int gw = vcu * 8 + wave, NGW = G * 8;
            const size_t gt = (size_t)vcu * 512 + tid, NGT = (size_t)G * 512;
            { u32x4* z = (u32x4*)(ws + WS_STATS); const size_t nz = (WS_ROPE - WS_STATS) / 16; for (size_t i = gt; i < nz; i += NGT) z[i] = (u32x4){0u, 0u, 0u, 0u}; }
            LAS float* scr = (LAS float*)(lds + wave * 16384);
            constexpr int I1 = 16 * 256, I1B = 16 * 96, I3R = 32 * 32, I3G = 16 * 32, I4 = 16 * 32;
            for (int it = gw; it < I1 + I1B + I3R + I3G + I4; it += NGW) {
                int q = it;
                if (q < I1) { const int kb = q / 256, nb = q % 256, n0 = 32 * nb; const int sc = n0 < 4096 ? n0 : (n0 < 6144 ? n0 + 2048 : n0 + 3088);
                    transpose_item(w_in, IN_COLS, (bf16_t*)(ws + WS_BT1), 1024, 0, 64 * kb, sc, n0, scr, lane); continue; } q -= I1;
                if (q < I1B) { const int kb = q / 96, nb = q % 96, n0 = 32 * nb; const int sc = n0 < 2048 ? n0 + 4096 : n0 + 6144;
                    transpose_item(w_in, IN_COLS, (bf16_t*)(ws + WS_BT1B), 1024, 0, 64 * kb, sc, n0, scr, lane); continue; } q -= I1B;
                if (q < I3R) { const int kb = q / 32, nb = q % 32; transpose_item(w_br, 1024, (bf16_t*)(ws + WS_BT3), 3072, 0, 64 * kb, 32 * nb, 32 * nb, scr, lane); continue; } q -= I3R;
                if (q < I3G) { const int kb = q / 32, nb = q % 32; transpose_item(w_bg, 1024, (bf16_t*)(ws + WS_BT3), 3072, 2048, 64 * kb, 32 * nb, 32 * nb, scr, lane); continue; } q -= I3G;
                { const int kb = q / 32, nb = q % 32; transpose_item(w_out, 1024, (bf16_t*)(ws + WS_BT4), 1024, 0, 64 * kb, 32 * nb, 32 * nb, scr, lane); }
            }
            for (size_t i = gt; i < (size_t)512 * 128; i += NGT) { const int n = (int)(i >> 7), k0 = (int)(i & 127) * 8; float up[16];
#pragma unroll
                for (int rr = 0; rr < 16; ++rr) up[rr] = w_gate_up[rr * 512 + n];
                float o[8];
#pragma unroll
                for (int j = 0; j < 8; ++j) { const float* wr_ = w_in + (size_t)(k0 + j) * IN_COLS + 9216; float s = 0.f;
#pragma unroll
                    for (int rr = 0; rr < 16; ++rr) s += wr_[rr] * up[rr];
                    o[j] = s; }
                u32x4 w; w.x = pk_bf16(o[0], o[1]); w.y = pk_bf16(o[2], o[3]); w.z = pk_bf16(o[4], o[5]); w.w = pk_bf16(o[6], o[7]);
                *(u32x4*)((bf16_t*)(ws + WS_BT1) + (size_t)(8192 + n) * 1024 + k0) = w; }
            for (size_t i = gt; i < (size_t)LTOK * 128; i += NGT) { const int t = (int)(i >> 7), d = (int)(i & 127);
                const float inv = exp2f(-(float)d * (13.287712379549449f / 128.0f));
                const float ang = (float)t * inv;
                const double rev = (double)ang * 0.15915494309189535; const double fr_ = rev - __builtin_rint(rev);
                const float f = (float)fr_;
                ((f32x2*)(ws + WS_ROPE))[i] = (f32x2){__builtin_amdgcn_cosf(f), __builtin_amdgcn_sinf(f)}; }
            bf16_t* U = (bf16_t*)(ws + WS_U);
            for (int m = gw; m < ROWS; m += NGW) {
                const int b = m / LP, p = m - b * LP;
                unsigned long long* o8 = (unsigned long long*)(U + (size_t)m * D) + lane;
                if (p < PADF) {
#pragma unroll
                    for (int j = 0; j < 4; ++j) o8[64 * j] = 0ull;
                    continue; }
                const float* src = p < 64 ? meta + (size_t)(p - PADF) * D : x + ((size_t)b * SEQ + (p - 64)) * D;
                const f32x4* xr = (const f32x4*)src + lane; const f32x4* gr = (const f32x4*)norm_gain + lane;
                f32x4 vv[4]; float s = 0.f;
#pragma unroll
                for (int j = 0; j < 4; ++j) { vv[j] = xr[64 * j]; s += (vv[j].x * vv[j].x + vv[j].y * vv[j].y) + (vv[j].z * vv[j].z + vv[j].w * vv[j].w); }
                const float rstd = 1.0f / sqrtf(wave_sum(s) * (1.0f / D) + EPS);
#pragma unroll
                for (int j = 0; j < 4; ++j) { const f32x4 gg = gr[64 * j]; const f32x4 y = vv[j] * rstd * gg;
                    o8[64 * j] = (unsigned long long)pk_bf16(y.x, y.y) | ((unsigned long long)pk_bf16(y.z, y.w) << 32); }
            }
        PH_END(0)
        PH_BEGIN(1)
            pg8::Gemm g{(const bf16_t*)(ws + WS_U), (const bf16_t*)(ws + WS_BT1), ROWS, N1, 1024, 0}; pg8::StaticOrder S; S.init(ROWS, N1, Go, bxo);
            EpiProj E{ws, srg, b_gate};
            pg8::gemm_phase<EpiProj>(lds, g, S, E, tid);
        PH_END(1)
        PH_BEGIN(2)
            const int xcd = bxo & 7, j = bxo >> 3;
            float* stats = (float*)(ws + WS_STATS);
            if (G == 256 && j < 16) {
                const int u = xcd * 16 + j, b = u >> 4, hh = (u >> 2) & 3, es = u & 3;
                const size_t r0 = (size_t)b * LP;
                const float g64 = exp2f(64.0f * __log2f(1.0f - exp2f(-5.0f - (float)hh)));
                scan_unit<256, false>(lds, (const bf16_t*)(ws + WS_RQ) + r0 * 1024 + hh * 256, (const bf16_t*)(ws + WS_RK) + r0 * 1024 + hh * 256,
                                      (bf16_t*)(ws + WS_RV) + r0 * 2048 + hh * 512 + es * 128, nullptr, stats + r0 * 16 + hh * 2, 1024, 2048, g64, tid);
            } else if (G == 256 && j < 24) {
                const int u = xcd * 8 + (j - 16), b = u >> 3, hh = (u >> 1) & 3, es = u & 1;
                const size_t r0 = (size_t)b * LP;
                scan_unit<128, true>(lds, (const bf16_t*)(ws + WS_GQ) + r0 * 512 + hh * 128, (const bf16_t*)(ws + WS_GK) + r0 * 512 + hh * 128,
                                     (bf16_t*)(ws + WS_GV) + r0 * 1024 + hh * 256 + es * 128, (const bf16_t*)(ws + WS_LA) + r0 * 512 + hh * 128, stats + r0 * 16 + (4 + hh) * 2, 512, 1024, 1.0f, tid);
            }
        PH_END(2)
        PH_BEGIN(3)
            pg8::Gemm g{(const bf16_t*)(ws + WS_U), (const bf16_t*)(ws + WS_BT1B), CROWS, N1B, 1024, 1}; pg8::StaticOrder S; S.init(CROWS, N1B, Go, bxo);
            EpiGate E{ws, ret_gain, gla_gain};
            pg8::gemm_phase<EpiGate>(lds, g, S, E, tid);
        PH_END(3)
        PH_BEGIN(4)
            pg8::Gemm g{(const bf16_t*)(ws + WS_RQ), (const bf16_t*)(ws + WS_BT3), CROWS, 1024, 3072, 0}; pg8::StaticOrder S; S.init(CROWS, 1024, Go, bxo);
            EpiMerge E{srg, (bf16_t*)(ws + WS_U)};
            pg8::gemm_phase<EpiMerge>(lds, g, S, E, tid);
        PH_END(4)
        PH_BEGIN(5)
            pg8::Gemm g{(const bf16_t*)(ws + WS_U), (const bf16_t*)(ws + WS_BT4), CROWS, 1024, 1024, 0}; pg8::StaticOrder S; S.init(CROWS, 1024, Go, bxo);
            EpiOut E{x, a.out, (float*)(ws + WS_ROWSS)};
            pg8::gemm_phase<EpiOut>(lds, g, S, E, tid);
        PH_END(5)
        PH_BEGIN(6)
            const int gw = vcu * 8 + wave, NGW = G * 8;
            const float* rowss = (const float*)(ws + WS_ROWSS);
            for (int m = gw; m < CROWS; m += NGW) {
                f32x4* yr = (f32x4*)(a.out + (size_t)m * D) + lane; const f32x4* gr = (const f32x4*)fgain + lane;
                const float rstd = 1.0f / sqrtf(rowss[m] * (1.0f / D) + EPS);
#pragma unroll
                for (int j = 0; j < 4; ++j) yr[64 * j] = yr[64 * j] * rstd * gr[64 * j];
            }
        PH_END(6)
    }
}

constexpr int N_PHASES = 7;
extern "C" void kernel_launch(void* const* d_in, const int* in_sizes, int n_in, void* d_out, int out_size, void* d_ws, size_t ws_size, hipStream_t stream) {
    static int grid = 0;
    if (grid == 0) {
        if (n_in != 12 || in_sizes[0] != CROWS * D || out_size != CROWS * D || ws_size < WS_END) {
            fprintf(stderr, "kernel_launch: unexpected shapes (n_in %d, in0 %d, out %d, ws %zu; need ws >= %zu); nothing launched\n", n_in, n_in > 0 ? in_sizes[0] : -1, out_size, ws_size, (size_t)WS_END); grid = -1; return; }
        int dev = 0, cus = 0, per_cu = 0;
        if (hipGetDevice(&dev) != hipSuccess || hipDeviceGetAttribute(&cus, hipDeviceAttributeMultiprocessorCount, dev) != hipSuccess) { fprintf(stderr, "kernel_launch: device query failed\n"); grid = -1; return; }
        if (hipFuncSetAttribute((const void*)mk_fwd, hipFuncAttributeMaxDynamicSharedMemorySize, LDS_BYTES) != hipSuccess) { fprintf(stderr, "kernel_launch: hipFuncSetAttribute failed\n"); grid = -1; return; }
        if (hipOccupancyMaxActiveBlocksPerMultiprocessor(&per_cu, (const void*)mk_fwd, 512, LDS_BYTES) != hipSuccess || per_cu < 1) { fprintf(stderr, "kernel_launch: occupancy query says %d blocks per CU\n", per_cu); (void)hipGetLastError(); grid = -1; return; }
        grid = cus;
        if (grid != 256) fprintf(stderr, "kernel_launch: note: %d CUs (the scan phase is laid out for 256)\n", grid);
    }
    if (grid < 0) return;
    Args a{};
    for (int i = 0; i < 12; ++i) a.in[i] = (const float*)d_in[i];
    a.out = (float*)d_out; a.ws = (unsigned char*)d_ws;
#if MK_N_LAUNCHES == 1
    a.ph_lo = 0; a.ph_hi = N_PHASES;
    void* args[] = {&a};
    hipError_t e = hipLaunchCooperativeKernel((const void*)mk_fwd, dim3(grid), dim3(512), args, LDS_BYTES, stream);
    if (e != hipSuccess) fprintf(stderr, "kernel_launch: cooperative launch failed: %s (grid %d)\n", hipGetErrorString(e), grid);
#else
    for (int p = 0; p < N_PHASES; ++p) {
        a.ph_lo = p; a.ph_hi = p + 1;
        hipLaunchKernelGGL(mk_fwd, dim3(grid), dim3(512), LDS_BYTES, stream, a);
    }
#endif
}
```

```cpp
#include <hip/hip_runtime.h>
#include <hip/hip_cooperative_groups.h>
#include <cstdio>
#include <cstdint>
namespace cg = cooperative_groups;

#ifndef MK_N_LAUNCHES
#define MK_N_LAUNCHES 1
#endif

#define LAS __attribute__((address_space(3)))
#define DI __device__ __forceinline__
typedef unsigned short bf16_t;
typedef short bf16x8 __attribute__((ext_vector_type(8)));
typedef short s16x4 __attribute__((ext_vector_type(4)));
typedef float f32x4 __attribute__((ext_vector_type(4)));
typedef float f32x2 __attribute__((ext_vector_type(2)));
typedef float f32x16 __attribute__((ext_vector_type(16)));
typedef unsigned u32x4 __attribute__((ext_vector_type(4)));
typedef unsigned u32x2 __attribute__((ext_vector_type(2)));
typedef __bf16 bf16x2_t __attribute__((ext_vector_type(2)));

constexpr int D = 1024, NB = 8, SEQ = 8192, NMETA = 16, LTOK = SEQ + NMETA;
constexpr int PADF = 48, LP = LTOK + PADF;
constexpr int ROWS = NB * LP;
constexpr int CROWS = NB * SEQ;
constexpr int IN_COLS = 11280;
constexpr int NCHUNK = LP / 64;
constexpr float EPS = 1e-6f;
constexpr int N1 = 8704, N1B = 3072;

constexpr size_t WS_CTL = 0;
constexpr size_t WS_STATS = 65536;
constexpr size_t WS_ROWSS = WS_STATS + (size_t)ROWS * 192;
constexpr size_t WS_ROPE = WS_ROWSS + (size_t)CROWS * 4;
constexpr size_t WS_BT1 = WS_ROPE + (size_t)LTOK * 128 * 8;
constexpr size_t WS_BT1B = WS_BT1 + (size_t)N1 * 1024 * 2;
constexpr size_t WS_BT3 = WS_BT1B + (size_t)N1B * 1024 * 2;
constexpr size_t WS_BT4 = WS_BT3 + (size_t)1024 * 3072 * 2;
constexpr size_t WS_U = WS_BT4 + (size_t)1024 * 1024 * 2;
constexpr size_t WS_RQ = WS_U + (size_t)ROWS * 2048;
constexpr size_t WS_RK = WS_RQ + (size_t)ROWS * 2048;
constexpr size_t WS_GQ = WS_RK + (size_t)ROWS * 2048;
constexpr size_t WS_GK = WS_GQ + (size_t)ROWS * 1024;
constexpr size_t WS_LA = WS_GK + (size_t)ROWS * 1024;
constexpr size_t WS_RV = WS_LA + (size_t)ROWS * 1024;
constexpr size_t WS_GV = WS_RV + (size_t)ROWS * 4096;
constexpr size_t WS_END = WS_GV + (size_t)ROWS * 2048;
static_assert(WS_END <= (size_t)1073741824, "workspace map exceeds 4x the largest tensor");
static_assert((size_t)CROWS * 3072 * 2 <= WS_RV - WS_RQ, "ACAT overlay");

constexpr int LDS_BYTES = 155648;
constexpr int SSL_OFF = 131072;

DI unsigned pk_bf16(float lo, float hi) { f32x2 v = {lo, hi}; bf16x2_t b = __builtin_convertvector(v, bf16x2_t); return __builtin_bit_cast(unsigned, b); }
DI float bf_lo(unsigned w) { return __uint_as_float(w << 16); }
DI float bf_hi(unsigned w) { return __uint_as_float(w & 0xffff0000u); }
DI float sigmoidf_(float x) { return __builtin_amdgcn_rcpf(1.0f + __expf(-x)); }

namespace pg8 {
constexpr int BM = 256, BK = 64, HALF = 128, HTB = HALF * BK * 2, STAGE_BYTES = 8 * HTB, NXCD = 8, WGM = 8;
__host__ __device__ __forceinline__ int lds_byte(int r, int c) { const int st = (r >> 4) * 2 + (c >> 5), rr = r & 15, cc = c & 31, ob = rr * 64 + cc * 2; return st * 1024 + (ob ^ (((ob >> 9) & 1) << 5)); }
__host__ __device__ __forceinline__ void stage_rc(int b, int& R, int& C) { const int st = b / 1024, sb = b % 1024, swz = sb ^ (((sb >> 9) & 1) << 5); R = (st >> 1) * 16 + swz / 64; C = (st & 1) * 32 + (swz % 64) / 2; }
__host__ __device__ __forceinline__ int perm32(int rho) { const int n = rho >> 4, i = rho & 15; return 8 * (i >> 2) + 4 * n + (i & 3); }

struct Unit { int pm, pn, am; };
struct Gemm { const bf16_t* A; const bf16_t* Bt; int M, N, K, amode; };
DI size_t a_row0(const Unit& u) { return u.am == 1 ? (size_t)((u.pm >> 5) * LP + 64 + (u.pm & 31) * 256) : (u.am == 2 ? (size_t)0 : (size_t)u.pm * 256); }

struct StaticOrder {
    int nM, nN, nwg, G, c, am;
    __host__ __device__ void init(int M, int N, int G_, int c_, int am_ = 0) { nM = M / BM; nN = N / BM; nwg = nM * nN; G = G_; c = c_; am = am_; }
    __host__ __device__ bool next(int i, Unit& u) const {
        const long L = (long)i * G + c; if (L >= nwg) return false;
        int wgid = (int)L; { const int q = nwg / NXCD, r = nwg % NXCD, xcd = wgid % NXCD, off = wgid / NXCD; wgid = (xcd < r ? xcd * (q + 1) : r * (q + 1) + (xcd - r) * q) + off; }
        const int nig = WGM * nN, gid = wgid / nig, fm = gid * WGM, gsz = (nM - fm) < WGM ? (nM - fm) : WGM;
        u.pm = fm + ((wgid % nig) % gsz); u.pn = (wgid % nig) / gsz; u.am = am; return true;
    }
};
constexpr int SIDE_X = 1076, SIDE_N5 = 1280, P1_MAIN = 258 * 26, P1_TOTAL = P1_MAIN + (SIDE_N5 - SIDE_X);
static_assert(P1_TOTAL % 256 == 0, "P1 units divide evenly over 256 workgroups");
struct P1Order {
    StaticOrder in; int G, c;
    __host__ __device__ void init(int G_, int c_) { in.init(258 * 256, 26 * 256, G_, c_, 0); G = G_; c = c_; }
    __host__ __device__ bool next(int i, Unit& u) const {
        const long L = (long)i * G + c;
        if (L < P1_MAIN) { in.next(i, u); if (u.pn >= 24) u.pn += 8; return true; }
        if (L >= P1_TOTAL) return false;
        const int s_ = SIDE_X + (int)(L - P1_MAIN); u.pm = s_ / 5; u.pn = 27 + s_ % 5; u.am = 1; return true;
    }
};
struct P3Order {
    int pm, pre;
    __host__ __device__ bool next(int i, Unit& u) const {
        u.pm = pm; u.am = 1;
        if (i < pre) { u.pn = 24 + i; return true; }
        if (i - pre < 12) { u.pn = 34 + (i - pre); return true; }
        const int j = i - 12;
        if (j < 3) { u.pn = 24 + j; return true; }
        return false;
    }
};
struct PanelOrder {
    int pm;
    int am;
    __host__ __device__ bool next(int i, Unit& u) const { if (i >= 4) return false; u.pm = pm; u.pn = i; u.am = am; return true; }
};
struct SideOrder {
    int start, count;
    __host__ __device__ bool next(int i, Unit& u) const { if (i >= count) return false; const int s_ = start + i; u.pm = s_ / 5; u.pn = 27 + s_ % 5; u.am = 1; return true; }
};

template <class Epi, class Sched>
DI void gemm_phase(LAS unsigned char* lds, const Gemm g, const Sched& S, const Epi& E, const int tid, const int stagger) {
    const int wid = __builtin_amdgcn_readfirstlane(tid >> 6), lane = tid & 63, wr = wid >> 2, wc = wid & 3, fr = lane & 15, fq = lane >> 4;
    const int K = g.K, nt = K / BK;
    unsigned voffA[2], voffB[2];
#pragma unroll
    for (int i = 0; i < 2; ++i) { int R, C; stage_rc(tid * 16 + i * 8192, R, C); const int Rb = Epi::PERM ? ((R & ~31) + perm32(R & 31)) : R;
        voffA[i] = (unsigned)(R * K + C) * 2u; voffB[i] = (unsigned)(Rb * K + C) * 2u; }
    const size_t kstep = (size_t)(BK * 2);
    const size_t hstep = (size_t)HALF * K * 2;
    const size_t tstep = 2 * hstep;
    const size_t rowb = (size_t)K * 2;
    const unsigned ldsw = (unsigned)wid * 1024u;
    const int aoff = lds_byte(wr * 64 + fr, fq * 8), boff = lds_byte(wc * 32 + fr, fq * 8);
#define PG8_SA(b, h) (((b) * 2 + (h)) * HTB)
#define PG8_SB(b, h) ((4 + (b) * 2 + (h)) * HTB)
#define PG8_STAGE(bufoff, gbase, voff) do { _Pragma("unroll") for (int _i = 0; _i < 2; ++_i) \
        __builtin_amdgcn_global_load_lds((const unsigned*)((const char*)(gbase) + (voff)[_i]), (LAS unsigned*)(lds + (bufoff) + ldsw + _i * 8192), 16, 0, 0); } while (0)
#define PG8_LDA(dst, b, h) do { _Pragma("unroll") for (int m = 0; m < 4; ++m) _Pragma("unroll") for (int k = 0; k < 2; ++k) dst[m][k] = *(const LAS bf16x8*)(lds + PG8_SA(b, h) + aoff + m * 2048 + k * 1024); } while (0)
#define PG8_LDB(dst, b, h) do { _Pragma("unroll") for (int n = 0; n < 2; ++n) _Pragma("unroll") for (int k = 0; k < 2; ++k) dst[n][k] = *(const LAS bf16x8*)(lds + PG8_SB(b, h) + boff + n * 2048 + k * 1024); } while (0)
#define PG8_MMA(ai, bj, At, Bt) do { __builtin_amdgcn_s_setprio(1); _Pragma("unroll") for (int m = 0; m < 4; ++m) _Pragma("unroll") for (int n = 0; n < 2; ++n) _Pragma("unroll") for (int k = 0; k < 2; ++k) \
        acc[ai][bj][m][n] = __builtin_amdgcn_mfma_f32_16x16x32_bf16(Bt[n][k], At[m][k], acc[ai][bj][m][n], 0, 0, 0); __builtin_amdgcn_s_setprio(0); } while (0)
#define PG8_WAIT_V(n) asm volatile("s_waitcnt vmcnt(" #n ")" ::: "memory")
#define PG8_WAIT_L(n) asm volatile("s_waitcnt lgkmcnt(" #n ")" ::: "memory")
#define PG8_BAR __builtin_amdgcn_s_barrier()
#define PG8_SCHED __builtin_amdgcn_sched_barrier(0)
    Unit cur, nxt; int ui = 0;
    if (!S.next(0, cur)) return;
    if (stagger > 0) { const unsigned long long t0 = __builtin_amdgcn_s_memrealtime(); const unsigned long long tgt = (unsigned long long)((((int)blockIdx.x >> 3) >> 3) & 3) * (unsigned)stagger;
        while (__builtin_amdgcn_s_memrealtime() - t0 < tgt) __builtin_amdgcn_s_sleep(16); }
    f32x4 acc[2][2][4][2];
#pragma unroll
    for (int a = 0; a < 2; ++a)
#pragma unroll
        for (int b = 0; b < 2; ++b)
#pragma unroll
            for (int m = 0; m < 4; ++m)
#pragma unroll
                for (int n = 0; n < 2; ++n) acc[a][b][m][n] = (f32x4){0.f, 0.f, 0.f, 0.f};
    bf16x8 At[4][2], B0[2][2], B1[2][2];
    const char* cA = (const char*)g.A + a_row0(cur) * rowb; const char* cB = (const char*)g.Bt + (size_t)cur.pn * tstep;
    PG8_STAGE(PG8_SB(0, 0), cB, voffB); PG8_STAGE(PG8_SB(0, 1), cB + hstep, voffB); PG8_STAGE(PG8_SA(0, 0), cA, voffA); PG8_STAGE(PG8_SA(0, 1), cA + hstep, voffA);
    if (wr == 1) PG8_BAR;
    PG8_WAIT_V(2); PG8_BAR;
    PG8_STAGE(PG8_SB(1, 0), cB + kstep, voffB); PG8_STAGE(PG8_SA(1, 0), cA + kstep, voffA); PG8_STAGE(PG8_SB(1, 1), cB + hstep + kstep, voffB);
    PG8_WAIT_V(6); PG8_BAR;
    for (;;) {
        const bool has_next = S.next(ui + 1, nxt);
        const char* nA = has_next ? (const char*)g.A + a_row0(nxt) * rowb : cA; const char* nB = has_next ? (const char*)g.Bt + (size_t)nxt.pn * tstep : cB;
        for (int t = 0; t < nt; t += 2) {
            if constexpr (Epi::MIDK >= 0) { if (t == Epi::MIDK) E.mid(acc, cur, wr, wc, fr, fq); }
            const bool last = (t == nt - 2);
            const char* a1 = cA + (size_t)(t + 1) * kstep;
            const char* a2 = last ? nA : cA + (size_t)(t + 2) * kstep; const char* b2 = last ? nB : cB + (size_t)(t + 2) * kstep;
            const char* a3 = a2 + kstep; const char* b3 = b2 + kstep;
            PG8_LDB(B0, 0, 0); PG8_LDB(B1, 0, 1); PG8_SCHED; PG8_LDA(At, 0, 0); PG8_STAGE(PG8_SA(1, 1), a1 + hstep, voffA);
            PG8_WAIT_V(8); PG8_WAIT_L(0); PG8_BAR; PG8_MMA(0, 0, At, B0); PG8_MMA(0, 1, At, B1); PG8_BAR; PG8_SCHED;
            PG8_LDA(At, 0, 1); PG8_STAGE(PG8_SB(0, 0), b2, voffB); PG8_STAGE(PG8_SB(0, 1), b2 + hstep, voffB); PG8_STAGE(PG8_SA(0, 0), a2, voffA);
            PG8_WAIT_V(8); PG8_WAIT_L(0); PG8_BAR; PG8_MMA(1, 0, At, B0); PG8_MMA(1, 1, At, B1); PG8_BAR; PG8_SCHED;
            PG8_LDB(B0, 1, 0); PG8_LDB(B1, 1, 1); PG8_SCHED; PG8_LDA(At, 1, 0); PG8_STAGE(PG8_SA(0, 1), a2 + hstep, voffA);
            PG8_WAIT_V(8); PG8_WAIT_L(0); PG8_BAR; PG8_MMA(0, 0, At, B0); PG8_MMA(0, 1, At, B1); PG8_BAR; PG8_SCHED;
            PG8_LDA(At, 1, 1); PG8_STAGE(PG8_SB(1, 0), b3, voffB); PG8_STAGE(PG8_SB(1, 1), b3 + hstep, voffB); PG8_STAGE(PG8_SA(1, 0), a3, voffA);
            PG8_WAIT_V(8); PG8_WAIT_L(0); PG8_BAR; PG8_MMA(1, 0, At, B0); PG8_MMA(1, 1, At, B1); PG8_BAR; PG8_SCHED;
        }
        if (wr == 0) PG8_BAR;
        E(acc, cur, wr, wc, fr, fq);
        if (!has_next) break;
#pragma unroll
        for (int a = 0; a < 2; ++a)
#pragma unroll
            for (int b = 0; b < 2; ++b)
#pragma unroll
                for (int m = 0; m < 4; ++m)
#pragma unroll
                    for (int n = 0; n < 2; ++n) acc[a][b][m][n] = (f32x4){0.f, 0.f, 0.f, 0.f};
        cur = nxt; cA = nA; cB = nB; ++ui;
        if (wr == 1) PG8_BAR;
    }
    PG8_WAIT_V(0);
    PG8_BAR;
#undef PG8_SA
#undef PG8_SB
#undef PG8_STAGE
#undef PG8_LDA
#undef PG8_LDB
#undef PG8_MMA
#undef PG8_WAIT_V
#undef PG8_WAIT_L
#undef PG8_BAR
#undef PG8_SCHED
}
}

typedef f32x4 Acc[2][2][4][2];

struct EpiProj {
    static constexpr bool PERM = true; static constexpr int MIDK = -1;
    unsigned char* ws; bf16_t* srg; const float* b_gate; int nostore;
    template <int MODE> DI void run(const Acc& acc, int row0, int cl, bf16_t* base, int pitch, int colt, int head) const {
        const float lg2 = __log2f(1.0f - exp2f(-5.0f - (float)head));
        float chi[8], clo[8];
        if (MODE == 4 || MODE == 5) { const f32x4* rc = (const f32x4*)((const f32x2*)(ws + WS_ROPE) + cl); const f32x4 c0 = rc[0], c1 = rc[1], c2 = rc[2], c3 = rc[3];
            chi[0] = c0[0]; clo[0] = c0[1]; chi[1] = c0[2]; clo[1] = c0[3]; chi[2] = c1[0]; clo[2] = c1[1]; chi[3] = c1[2]; clo[3] = c1[3];
            chi[4] = c2[0]; clo[4] = c2[1]; chi[5] = c2[2]; clo[5] = c2[3]; chi[6] = c3[0]; clo[6] = c3[1]; chi[7] = c3[2]; clo[7] = c3[3]; }
#pragma unroll
        for (int ai = 0; ai < 2; ++ai)
#pragma unroll
            for (int m = 0; m < 4; ++m) {
                const int row = row0 + ai * 128 + m * 16;
                const int b = row / LP, p = row - b * LP;
                if (MODE == 2) {
                    if (p < 64) continue;
                    bf16_t* rowp = base + (size_t)(b * SEQ + p - 64) * pitch + colt + cl;
#pragma unroll
                    for (int bj = 0; bj < 2; ++bj) { const f32x4 v0 = acc[ai][bj][m][0], v1 = acc[ai][bj][m][1]; u32x4 w;
                        w.x = pk_bf16(sigmoidf_(v0[0]), sigmoidf_(v0[1])); w.y = pk_bf16(sigmoidf_(v0[2]), sigmoidf_(v0[3]));
                        w.z = pk_bf16(sigmoidf_(v1[0]), sigmoidf_(v1[1])); w.w = pk_bf16(sigmoidf_(v1[2]), sigmoidf_(v1[3]));
                        if (nostore) asm volatile("" :: "v"(w)); else __builtin_nontemporal_store(w, (u32x4*)(rowp + bj * 128)); }
                } else if (MODE == 4 || MODE == 5) {
                    bf16_t* rowp = base + (size_t)row * pitch + colt + cl;
                    const int t = p >= PADF ? p - PADF : 0;
                    const float tf = (float)t;
                    const float ic = (float)(p & 63);
                    const float sc = MODE == 4 ? exp2f(ic * lg2) : 0.0625f * exp2f(-ic * lg2);
                    const f32x4 a0 = acc[ai][0][m][0], a1 = acc[ai][0][m][1], c0 = acc[ai][1][m][0], c1 = acc[ai][1][m][1];
                    float o1[8], o2[8];
                    float cs[8], sn[8];
#pragma unroll
                    for (int j = 0; j < 8; ++j) { const float p0 = tf * chi[j]; const float rev = (p0 - floorf(p0)) + tf * clo[j]; cs[j] = __builtin_amdgcn_cosf(rev); sn[j] = __builtin_amdgcn_sinf(rev); }
                    const float t1[8] = {a0[0], a0[1], a0[2], a0[3], a1[0], a1[1], a1[2], a1[3]};
                    const float t2[8] = {c0[0], c0[1], c0[2], c0[3], c1[0], c1[1], c1[2], c1[3]};
#pragma unroll
                    for (int j = 0; j < 8; ++j) { o1[j] = (t1[j] * cs[j] - t2[j] * sn[j]) * sc; o2[j] = (t2[j] * cs[j] + t1[j] * sn[j]) * sc; }
                    u32x4 w1, w2;
                    w1.x = pk_bf16(o1[0], o1[1]); w1.y = pk_bf16(o1[2], o1[3]); w1.z = pk_bf16(o1[4], o1[5]); w1.w = pk_bf16(o1[6], o1[7]);
                    w2.x = pk_bf16(o2[0], o2[1]); w2.y = pk_bf16(o2[2], o2[3]); w2.z = pk_bf16(o2[4], o2[5]); w2.w = pk_bf16(o2[6], o2[7]);
                    if (nostore) { asm volatile("" :: "v"(w1), "v"(w2)); } else { __builtin_nontemporal_store(w1, (u32x4*)(rowp)); __builtin_nontemporal_store(w2, (u32x4*)(rowp + 128)); }
                } else {
                    bf16_t* rowp = base + (size_t)row * pitch + colt + cl;
#pragma unroll
                    for (int bj = 0; bj < 2; ++bj) { f32x4 v0 = acc[ai][bj][m][0], v1 = acc[ai][bj][m][1];
                        if (MODE == 1) { v0 = v0 * 0.08838834764831845f; v1 = v1 * 0.08838834764831845f; }
                        if (MODE == 3) {
                            const f32x4 g0 = *(const f32x4*)(b_gate + colt + cl + bj * 128), g1 = *(const f32x4*)(b_gate + colt + cl + bj * 128 + 4);
                            v0 = v0 + g0; v1 = v1 + g1;
#pragma unroll
                            for (int j = 0; j < 4; ++j) { v0[j] = -0.0625f * (fmaxf(-v0[j], 0.f) + __logf(1.0f + __expf(-fabsf(v0[j])))); v1[j] = -0.0625f * (fmaxf(-v1[j], 0.f) + __logf(1.0f + __expf(-fabsf(v1[j])))); }
                        }
                        u32x4 w; w.x = pk_bf16(v0[0], v0[1]); w.y = pk_bf16(v0[2], v0[3]); w.z = pk_bf16(v1[0], v1[1]); w.w = pk_bf16(v1[2], v1[3]);
                        if (nostore) asm volatile("" :: "v"(w)); else __builtin_nontemporal_store(w, (u32x4*)(rowp + bj * 128)); }
                }
            }
    }
    DI void run_decay(const Acc& acc, int row0, int cl, bf16_t* base, int colt, int lane) const {
#pragma unroll
        for (int ai = 0; ai < 2; ++ai)
#pragma unroll
            for (int bj = 0; bj < 2; ++bj) {
                const f32x4 g0 = *(const f32x4*)(b_gate + colt + cl + bj * 128), g1 = *(const f32x4*)(b_gate + colt + cl + bj * 128 + 4);
                float v[4][8];
#pragma unroll
                for (int m = 0; m < 4; ++m) {
                    const int row = row0 + ai * 128 + m * 16; const int b = row / LP, p = row - b * LP;
                    const f32x4 a0 = acc[ai][bj][m][0] + g0, a1 = acc[ai][bj][m][1] + g1;
                    const float t[8] = {a0[0], a0[1], a0[2], a0[3], a1[0], a1[1], a1[2], a1[3]};
#pragma unroll
                    for (int j = 0; j < 8; ++j) { float x = -0.0625f * (fmaxf(-t[j], 0.f) + __logf(1.0f + __expf(-fabsf(t[j])))); if (p < PADF) x = 0.f;
                        x += __int_as_float(__builtin_amdgcn_update_dpp(0, __float_as_int(x), 0x111, 0xF, 0xF, true));
                        x += __int_as_float(__builtin_amdgcn_update_dpp(0, __float_as_int(x), 0x112, 0xF, 0xF, true));
                        x += __int_as_float(__builtin_amdgcn_update_dpp(0, __float_as_int(x), 0x114, 0xF, 0xF, true));
                        x += __int_as_float(__builtin_amdgcn_update_dpp(0, __float_as_int(x), 0x118, 0xF, 0xF, true));
                        v[m][j] = x; }
                }
                const int bsrc = ((lane & 48) | 15) * 4;
#pragma unroll
                for (int m = 1; m < 4; ++m)
#pragma unroll
                    for (int j = 0; j < 8; ++j) v[m][j] += __int_as_float(__builtin_amdgcn_ds_bpermute(bsrc, __float_as_int(v[m - 1][j])));
#pragma unroll
                for (int m = 0; m < 4; ++m) {
                    const int row = row0 + ai * 128 + m * 16;
                    u32x4 w; w.x = pk_bf16(__expf(v[m][0]), __expf(v[m][1])); w.y = pk_bf16(__expf(v[m][2]), __expf(v[m][3])); w.z = pk_bf16(__expf(v[m][4]), __expf(v[m][5])); w.w = pk_bf16(__expf(v[m][6]), __expf(v[m][7]));
                    if (nostore) asm volatile("" :: "v"(w)); else __builtin_nontemporal_store(w, (u32x4*)(base + (size_t)row * 512 + colt + cl + bj * 128));
                }
            }
    }
    DI void operator()(const Acc& acc, const pg8::Unit& u, int wr, int wc, int fr, int fq) const {
        asm volatile("" : "+v"(fr), "+v"(fq));
        const int row0 = (int)pg8::a_row0(u) + wr * 64 + fr, cl = wc * 32 + 8 * fq, pn = u.pn;
        if (pn < 4)       run<4>(acc, row0, cl, (bf16_t*)(ws + WS_RQ), 1024, 256 * pn, pn);
        else if (pn < 8)  run<5>(acc, row0, cl, (bf16_t*)(ws + WS_RK), 1024, 256 * (pn - 4), pn - 4);
        else if (pn < 16) run<0>(acc, row0, cl, (bf16_t*)(ws + WS_RV), 2048, 256 * (pn - 8), 0);
        else if (pn < 18) run<1>(acc, row0, cl, (bf16_t*)(ws + WS_GQ), 512, 256 * (pn - 16), 0);
        else if (pn < 20) run<0>(acc, row0, cl, (bf16_t*)(ws + WS_GK), 512, 256 * (pn - 18), 0);
        else if (pn < 24) run<0>(acc, row0, cl, (bf16_t*)(ws + WS_GV), 1024, 256 * (pn - 20), 0);
        else if (pn < 32) run<2>(acc, row0, cl, srg, 2048, 256 * (pn - 24), 0);
        else              run_decay(acc, row0, cl, (bf16_t*)(ws + WS_LA), 256 * (pn - 32), fq * 16 + fr);
    }
};

struct EpiDry {
    static constexpr bool PERM = true; static constexpr int MIDK = -1;
    DI void operator()(const Acc& acc, const pg8::Unit& u, int wr, int wc, int fr, int fq) const {
#pragma unroll
        for (int ai = 0; ai < 2; ++ai)
#pragma unroll
            for (int bj = 0; bj < 2; ++bj)
#pragma unroll
                for (int m = 0; m < 4; ++m)
#pragma unroll
                    for (int n = 0; n < 2; ++n) asm volatile("" :: "v"(acc[ai][bj][m][n]));
    }
};
struct EpiGate {
    static constexpr bool PERM = true; static constexpr int MIDK = -1;
    unsigned char* ws; const float* ret_gain; const float* gla_gain; LAS float* tab;
    DI void operator()(const Acc& acc, const pg8::Unit& u, int wr, int wc, int fr, int fq) const {
        asm volatile("" : "+v"(fr), "+v"(fq));
        const int pn = u.pn - 34, pm = u.pm, cl = wc * 32 + 8 * fq;
        const bool ret = pn < 8;
        const int col0 = ret ? 256 * pn : 256 * (pn - 8);
        const int slot = ret ? (pn >> 1) * 4 : 16 + (pn - 8) * 2;
        const bf16_t* O = (const bf16_t*)(ws + (ret ? WS_RV : WS_GV)); const int opitch = ret ? 2048 : 1024;
        const float* gain = (ret ? ret_gain : gla_gain) + col0 + cl;
        const float invn = ret ? (1.0f / 512.0f) : (1.0f / 256.0f);
        const float* stats = (const float*)(ws + WS_STATS);
        bf16_t* acat = (bf16_t*)(ws + WS_RQ);
        const int acol = (ret ? 0 : 2048) + col0 + cl;
        const size_t prow0 = (size_t)((pm >> 5) * LP + 64 + (pm & 31) * 256), crow0 = (size_t)pm * 256;
        { const int t_ = ((wr * 4 + wc) << 6) + fq * 16 + fr;
          if (t_ < 256) { const float* sp = stats + (prow0 + t_) * 48 + slot * 2; f32x4 p = *(const f32x4*)sp; if (ret) p = p + *(const f32x4*)(sp + 4);
              const float sm = p[0] + p[2], sq = p[1] + p[3];
              const float mu = ret ? sm * invn : 0.f; const float var = sq * invn - mu * mu; const float rs = __builtin_amdgcn_rsqf(fmaxf(var, 0.f) + EPS);
              *(LAS f32x2*)(tab + 2 * t_) = (f32x2){rs, -mu * rs}; }
          asm volatile("s_waitcnt lgkmcnt(0)" ::: "memory"); __builtin_amdgcn_s_barrier(); asm volatile("" ::: "memory"); }
        f32x4 gn[2][2];
#pragma unroll
        for (int bj = 0; bj < 2; ++bj) { gn[bj][0] = *(const f32x4*)(gain + bj * 128); gn[bj][1] = *(const f32x4*)(gain + bj * 128 + 4); }
        u32x4 ov[4][2];
#define GATE_LD(g_) do { const int rr_ = ((g_) >> 2) * 128 + wr * 64 + ((g_) & 3) * 16 + fr; const bf16_t* orow = O + (prow0 + rr_) * opitch + col0 + cl; \
            ov[(g_) & 3][0] = *(const u32x4*)(orow); ov[(g_) & 3][1] = *(const u32x4*)(orow + 128); } while (0)
#pragma unroll
        for (int g = 0; g < 4; ++g) GATE_LD(g);
#pragma unroll
        for (int g = 0; g < 8; ++g) {
            const int ai = g >> 2, m = g & 3;
            const int rr = ai * 128 + wr * 64 + m * 16 + fr;
            const f32x2 ab = *(const LAS f32x2*)(tab + 2 * rr);
            bf16_t* arow = acat + (crow0 + rr) * 3072 + acol;
            u32x4 wv[2];
#pragma unroll
            for (int bj = 0; bj < 2; ++bj) {
                const u32x4 o4 = ov[g & 3][bj];
                const f32x4 v0 = acc[ai][bj][m][0], v1 = acc[ai][bj][m][1];
                const float o[8] = {bf_lo(o4.x), bf_hi(o4.x), bf_lo(o4.y), bf_hi(o4.y), bf_lo(o4.z), bf_hi(o4.z), bf_lo(o4.w), bf_hi(o4.w)};
                const float gt[8] = {v0[0], v0[1], v0[2], v0[3], v1[0], v1[1], v1[2], v1[3]};
                const float gg[8] = {gn[bj][0][0], gn[bj][0][1], gn[bj][0][2], gn[bj][0][3], gn[bj][1][0], gn[bj][1][1], gn[bj][1][2], gn[bj][1][3]};
                float r[8];
#pragma unroll
                for (int j = 0; j < 8; ++j) r[j] = (o[j] * ab.x + ab.y) * gg[j] * (gt[j] * sigmoidf_(gt[j]));
                wv[bj].x = pk_bf16(r[0], r[1]); wv[bj].y = pk_bf16(r[2], r[3]); wv[bj].z = pk_bf16(r[4], r[5]); wv[bj].w = pk_bf16(r[6], r[7]);
            }
            if (g + 4 < 8) GATE_LD(g + 4);
            *(u32x4*)(arow) = wv[0]; *(u32x4*)(arow + 128) = wv[1];
            asm volatile("" ::: "memory");
        }
#undef GATE_LD
    }
};
struct EpiP3 {
    static constexpr bool PERM = true; static constexpr int MIDK = -1;
    EpiProj a; EpiGate b;
    DI void operator()(const Acc& acc, const pg8::Unit& u, int wr, int wc, int fr, int fq) const { if (u.pn >= 34) b(acc, u, wr, wc, fr, fq); else a(acc, u, wr, wc, fr, fq); }
};
struct EpiMerge {
    static constexpr bool PERM = true; static constexpr int MIDK = 32;
    const bf16_t* srg; bf16_t* merged;
    DI void mid(Acc& acc, const pg8::Unit& u, int wr, int wc, int fr, int fq) const {
        asm volatile("" : "+v"(fr), "+v"(fq));
        const int col = 256 * u.pn + wc * 32 + 8 * fq;
#pragma unroll
        for (int ai = 0; ai < 2; ++ai) {
            u32x4 sv[4][2], gv[4][2];
#pragma unroll
            for (int m = 0; m < 4; ++m) {
                const size_t row = (size_t)u.pm * 256 + ai * 128 + wr * 64 + m * 16 + fr;
#pragma unroll
                for (int bj = 0; bj < 2; ++bj) { sv[m][bj] = *(const u32x4*)(srg + row * 2048 + col + bj * 128); gv[m][bj] = *(const u32x4*)(srg + row * 2048 + 1024 + col + bj * 128); }
            }
#pragma unroll
            for (int m = 0; m < 4; ++m)
#pragma unroll
                for (int bj = 0; bj < 2; ++bj) {
                    const u32x4 s4 = sv[m][bj], g4 = gv[m][bj];
                    f32x4 r0 = {bf_lo(s4.x) * __builtin_amdgcn_rcpf(bf_lo(g4.x)), bf_hi(s4.x) * __builtin_amdgcn_rcpf(bf_hi(g4.x)), bf_lo(s4.y) * __builtin_amdgcn_rcpf(bf_lo(g4.y)), bf_hi(s4.y) * __builtin_amdgcn_rcpf(bf_hi(g4.y))};
                    f32x4 r1 = {bf_lo(s4.z) * __builtin_amdgcn_rcpf(bf_lo(g4.z)), bf_hi(s4.z) * __builtin_amdgcn_rcpf(bf_hi(g4.z)), bf_lo(s4.w) * __builtin_amdgcn_rcpf(bf_lo(g4.w)), bf_hi(s4.w) * __builtin_amdgcn_rcpf(bf_hi(g4.w))};
                    acc[ai][bj][m][0] = acc[ai][bj][m][0] * r0; acc[ai][bj][m][1] = acc[ai][bj][m][1] * r1;
                }
            asm volatile("" ::: "memory");
        }
    }
    DI void operator()(const Acc& acc, const pg8::Unit& u, int wr, int wc, int fr, int fq) const {
        asm volatile("" : "+v"(fr), "+v"(fq));
        const int col = 256 * u.pn + wc * 32 + 8 * fq;
#pragma unroll
        for (int ai = 0; ai < 2; ++ai) {
            u32x4 gv[4][2];
#pragma unroll
            for (int m = 0; m < 4; ++m) {
                const size_t row = (size_t)u.pm * 256 + ai * 128 + wr * 64 + m * 16 + fr;
#pragma unroll
                for (int bj = 0; bj < 2; ++bj) gv[m][bj] = *(const u32x4*)(srg + row * 2048 + 1024 + col + bj * 128);
            }
#pragma unroll
            for (int m = 0; m < 4; ++m) {
                const size_t row = (size_t)u.pm * 256 + ai * 128 + wr * 64 + m * 16 + fr;
#pragma unroll
                for (int bj = 0; bj < 2; ++bj) {
                    const u32x4 g4 = gv[m][bj];
                    const f32x4 v0 = acc[ai][bj][m][0], v1 = acc[ai][bj][m][1];
                    u32x4 w; w.x = pk_bf16(v0[0] * bf_lo(g4.x), v0[1] * bf_hi(g4.x)); w.y = pk_bf16(v0[2] * bf_lo(g4.y), v0[3] * bf_hi(g4.y));
                    w.z = pk_bf16(v1[0] * bf_lo(g4.z), v1[1] * bf_hi(g4.z)); w.w = pk_bf16(v1[2] * bf_lo(g4.w), v1[3] * bf_hi(g4.w));
                    *(u32x4*)(merged + (size_t)(ai * 128 + wr * 64 + m * 16 + fr) * 1024 + col + bj * 128) = w;
                }
            }
            asm volatile("" ::: "memory");
        }
    }
};

struct EpiOut {
    static constexpr bool PERM = true; static constexpr int MIDK = -1;
    const float* x; bf16_t* yb; LAS float* ssl;
    DI void operator()(const Acc& acc, const pg8::Unit& u, int wr, int wc, int fr, int fq) const {
        asm volatile("" : "+v"(fr), "+v"(fq));
        const int col = 256 * u.pn + wc * 32 + 8 * fq;
#pragma unroll
        for (int ai = 0; ai < 2; ++ai)
#pragma unroll
            for (int m = 0; m < 4; ++m) {
                const size_t row = (size_t)u.pm * 256 + ai * 128 + wr * 64 + m * 16 + fr;
                float ss = 0.f;
#pragma unroll
                for (int bj = 0; bj < 2; ++bj) {
                    const size_t o = row * 1024 + col + bj * 128, ol = (size_t)(ai * 128 + wr * 64 + m * 16 + fr) * 1024 + col + bj * 128;
                    const f32x4 v0 = *(const f32x4*)(x + o) + acc[ai][bj][m][0], v1 = *(const f32x4*)(x + o + 4) + acc[ai][bj][m][1];
                    ss += (v0[0] * v0[0] + v0[1] * v0[1]) + (v0[2] * v0[2] + v0[3] * v0[3]) + (v1[0] * v1[0] + v1[1] * v1[1]) + (v1[2] * v1[2] + v1[3] * v1[3]);
                    u32x4 w; w.x = pk_bf16(v0[0], v0[1]); w.y = pk_bf16(v0[2], v0[3]); w.z = pk_bf16(v1[0], v1[1]); w.w = pk_bf16(v1[2], v1[3]);
                    *(u32x4*)(yb + ol) = w;
                }
                ss += __shfl_xor(ss, 16); ss += __shfl_xor(ss, 32);
                if (fq == 0) ssl[(u.pn * 4 + wc) * 256 + ai * 128 + wr * 64 + m * 16 + fr] = ss;
                asm volatile("" ::: "memory");
            }
    }
};

DI unsigned img_off(unsigned row, unsigned ch) {
    return ((ch >> 4) * 64u + row) * 256u + 16u * ((ch & 15u) ^ (((row & 3u) << 2) | ((row >> 2) & 3u)));
}
DI s16x4 tr4(const LAS unsigned char* p) { return __builtin_bit_cast(s16x4, __builtin_amdgcn_ds_read_tr16_b64_v4i16((LAS s16x4*)p)); }
DI bf16x8 tr_frag(const LAS unsigned char* base, int ks, int c, int lane) {
    const unsigned h = lane >> 5, blk = (lane >> 4) & 1, q = (lane & 15) >> 2, p = lane & 3;
    const unsigned ch = 4 * c + 2 * blk + (p >> 1), r0 = 16 * ks + 8 * h + q;
    const s16x4 lo = tr4(base + img_off(r0, ch) + 8 * (p & 1));
    const s16x4 hi = tr4(base + img_off(r0 + 4, ch) + 8 * (p & 1));
    return __builtin_shufflevector(lo, hi, 0, 1, 2, 3, 4, 5, 6, 7);
}
DI bf16x8 pack8(const f32x16& x, int s) {
    u32x4 p; p.x = pk_bf16(x[8 * s], x[8 * s + 1]); p.y = pk_bf16(x[8 * s + 2], x[8 * s + 3]); p.z = pk_bf16(x[8 * s + 4], x[8 * s + 5]); p.w = pk_bf16(x[8 * s + 6], x[8 * s + 7]);
    return __builtin_bit_cast(bf16x8, p);
}
#define MFMA32(a, b, c) __builtin_amdgcn_mfma_f32_32x32x16_bf16((a), (b), (c), 0, 0, 0)

#define SCAN_FLUSH(NN) do { const int tt = tid - 256, row = tt >> 2, qt = tt & 3; \
          const LAS u32x4* op = (const LAS u32x4*)(lds + OS + row * 272 + qt * 64); \
          const u32x4 w0 = op[0], w1 = op[1], w2 = op[2], w3 = op[3]; \
          float s_ = 0.f, ss_ = 0.f; \
          { const unsigned ww[16] = {w0.x, w0.y, w0.z, w0.w, w1.x, w1.y, w1.z, w1.w, w2.x, w2.y, w2.z, w2.w, w3.x, w3.y, w3.z, w3.w}; \
            _Pragma("unroll") for (int j = 0; j < 16; ++j) { const float a_ = bf_lo(ww[j]), b_ = bf_hi(ww[j]); s_ += a_ + b_; ss_ += a_ * a_ + b_ * b_; } } \
          s_ += __shfl_xor(s_, 1); ss_ += __shfl_xor(ss_, 1); s_ += __shfl_xor(s_, 2); ss_ += __shfl_xor(ss_, 2); \
          const size_t grow = (size_t)(NN) * 64 + row; \
          if (!dry) { if (qt == 0) *(f32x2*)(statp + grow * 48) = (f32x2){s_, ss_}; \
              u32x4* gp = (u32x4*)(Vg + grow * vp + qt * 32); gp[0] = w0; gp[1] = w1; gp[2] = w2; gp[3] = w3; } } while (0)
template <int DK, bool GLA>
DI void scan_unit(LAS unsigned char* lds, const bf16_t* Qg, const bf16_t* Kg, bf16_t* Vg, const bf16_t* LAg, float* statp, int qkp, int vp, float g64, const int tid, const int dry) {
    constexpr int NT = DK / 64;
    constexpr int NQ = DK / 64;
    constexpr int CPR = DK / 8;
    constexpr int QP = DK * 2 + 16, VP = 320;
    constexpr int QS = 0, KS = QS + 64 * QP, VS = KS + 64 * DK * 2, PS = VS + 64 * VP, XS = PS + 64 * 144, OS = XS + 32768, GS = OS + 64 * 272, END = GS + 512;
    static_assert(END <= LDS_BYTES - 256, "scan LDS map");
    const int lane0 = tid & 63, v = __builtin_amdgcn_readfirstlane(tid >> 6), et = v & 3, kh = v >> 2;
    f32x16 S[NT];
#pragma unroll
    for (int kt = 0; kt < NT; ++kt)
#pragma unroll
        for (int i = 0; i < 16; ++i) S[kt][i] = 0.f;
    u32x4 qreg[NQ], kreg[NQ], vreg[2], lreg[2];
    auto load_chunk = [&](int n) {
        const size_t row0 = (size_t)n * 64;
#pragma unroll
        for (int i = 0; i < NQ; ++i) { const int pi = tid + 512 * i, row = pi / CPR, ch = pi % CPR;
            qreg[i] = *(const u32x4*)(Qg + (row0 + row) * qkp + ch * 8); kreg[i] = *(const u32x4*)(Kg + (row0 + row) * qkp + ch * 8);
            if (GLA) lreg[i] = *(const u32x4*)(LAg + (row0 + row) * qkp + ch * 8); }
#pragma unroll
        for (int i = 0; i < 2; ++i) { const int pi = tid + 512 * i, row = pi >> 4, ch = pi & 15; vreg[i] = *(const u32x4*)(Vg + (row0 + row) * vp + ch * 8); }
    };
    load_chunk(0);
    for (int n = 0; n < NCHUNK; ++n) {
        int lane = lane0; asm volatile("" : "+v"(lane));
        const int r = lane & 31, h = lane >> 5;
        if (GLA) {
#pragma unroll
            for (int i = 0; i < 2; ++i) { const int pi = tid + 512 * i, row = pi >> 4, ch = pi & 15;
                const u32x4 w = lreg[i];
                const float e[8] = {bf_lo(w.x), bf_hi(w.x), bf_lo(w.y), bf_hi(w.y), bf_lo(w.z), bf_hi(w.z), bf_lo(w.w), bf_hi(w.w)};
                float ei[8];
#pragma unroll
                for (int j = 0; j < 8; ++j) ei[j] = __builtin_amdgcn_rcpf(e[j]);
                const u32x4 qw = qreg[i], kw = kreg[i]; u32x4 qo, ko;
                qo.x = pk_bf16(bf_lo(qw.x) * e[0], bf_hi(qw.x) * e[1]); qo.y = pk_bf16(bf_lo(qw.y) * e[2], bf_hi(qw.y) * e[3]); qo.z = pk_bf16(bf_lo(qw.z) * e[4], bf_hi(qw.z) * e[5]); qo.w = pk_bf16(bf_lo(qw.w) * e[6], bf_hi(qw.w) * e[7]);
                ko.x = pk_bf16(bf_lo(kw.x) * ei[0], bf_hi(kw.x) * ei[1]); ko.y = pk_bf16(bf_lo(kw.y) * ei[2], bf_hi(kw.y) * ei[3]); ko.z = pk_bf16(bf_lo(kw.z) * ei[4], bf_hi(kw.z) * ei[5]); ko.w = pk_bf16(bf_lo(kw.w) * ei[6], bf_hi(kw.w) * ei[7]);
                *(LAS u32x4*)(lds + QS + row * QP + ch * 16) = qo; *(LAS u32x4*)(lds + KS + img_off(row, ch)) = ko;
                if (row == 63) { LAS float* gp = (LAS float*)(lds + GS) + ch * 8; *(LAS f32x4*)gp = (f32x4){e[0], e[1], e[2], e[3]}; *(LAS f32x4*)(gp + 4) = (f32x4){e[4], e[5], e[6], e[7]}; } }
        } else {
#pragma unroll
            for (int i = 0; i < NQ; ++i) { const int pi = tid + 512 * i, row = pi / CPR, ch = pi % CPR;
                *(LAS u32x4*)(lds + QS + row * QP + ch * 16) = qreg[i]; *(LAS u32x4*)(lds + KS + img_off(row, ch)) = kreg[i]; }
        }
#pragma unroll
        for (int i = 0; i < 2; ++i) { const int pi = tid + 512 * i, row = pi >> 4, ch = pi & 15; *(LAS u32x4*)(lds + VS + row * VP + ch * 16) = vreg[i]; }
        __syncthreads();
        if (n + 1 < NCHUNK) load_chunk(n + 1);
        const unsigned rowb0 = (unsigned)r * 256u, xr = 16u * ((((unsigned)r & 3u) << 2) | (((unsigned)r >> 2) & 3u));
#define ROWA(base, rt, ch) ((base) + ((ch) >> 4) * 16384 + (rt) * 8192 + rowb0 + ((16u * ((ch) & 15u)) ^ xr))
        if (v < 3) {
            const int jt = v >> 1, it = (v + 1) >> 1;
            const LAS unsigned char* kb = lds + KS + jt * 8192 + 16 * h; const LAS unsigned char* qb = lds + QS + it * 8192 + 16 * h;
            const unsigned xh = xr ^ (16u * (unsigned)h);
#define SCA(s_) (*(const LAS bf16x8*)(kb - 16 * h + (((2 * (s_)) >> 4) * 16384) + rowb0 + ((32u * ((s_) & 7u)) ^ xh)))
#define SCB(s_) (*(const LAS bf16x8*)(lds + QS + (32 * it + r) * QP + 16 * h + 32 * (s_)))
            constexpr int NS = DK / 16;
            bf16x8 fa[4], fb[4];
#pragma unroll
            for (int s = 0; s < 4; ++s) { fa[s] = SCA(s); fb[s] = SCB(s); }
            f32x16 p;
#pragma unroll
            for (int i = 0; i < 16; ++i) p[i] = 0.f;
#pragma unroll
            for (int s = 0; s < NS; ++s) {
                p = MFMA32(fa[s & 3], fb[s & 3], p);
                if (s + 4 < NS) { fa[s & 3] = SCA(s + 4); fb[s & 3] = SCB(s + 4); }
            }
#undef SCA
#undef SCB
            const bool diag = (jt == it);
#pragma unroll
            for (int g = 0; g < 4; ++g) {
                float x[4];
#pragma unroll
                for (int j = 0; j < 4; ++j) { const int jl = 8 * g + 4 * h + j; x[j] = (!diag || r >= jl) ? p[4 * g + j] : 0.f; }
                u32x2 w; w.x = pk_bf16(x[0], x[1]); w.y = pk_bf16(x[2], x[3]);
                *(LAS u32x2*)(lds + PS + (32 * it + r) * 144 + (32 * jt + 8 * g + 4 * h) * 2) = w;
            }
        }
        f32x16 keep, send;
#pragma unroll
        for (int i = 0; i < 16; ++i) { keep[i] = 0.f; send[i] = 0.f; }
        {
            const LAS unsigned char* qown = lds + QS + (32 * kh + r) * QP + 16 * h + kh * DK;
            const LAS unsigned char* qoth = lds + QS + (32 * (1 - kh) + r) * QP + 16 * h + kh * DK;
            bf16x8 qf[2][4];
#pragma unroll
            for (int f = 0; f < 4; ++f) qf[0][f] = *(const LAS bf16x8*)(((f >> 1) ? qoth : qown) + 32 * (f & 1));
#pragma unroll
            for (int kt = 0; kt < NT; ++kt) {
                if (kt + 1 < NT) {
#pragma unroll
                    for (int f = 0; f < 4; ++f) qf[(kt + 1) & 1][f] = *(const LAS bf16x8*)(((f >> 1) ? qoth : qown) + 64 * (kt + 1) + 32 * (f & 1));
                }
                bf16x8 xs[2];
#pragma unroll
                for (int s2 = 0; s2 < 2; ++s2) {
                    u32x4 p; p.x = pk_bf16(S[kt][8 * s2], S[kt][8 * s2 + 1]); p.y = pk_bf16(S[kt][8 * s2 + 2], S[kt][8 * s2 + 3]); p.z = pk_bf16(S[kt][8 * s2 + 4], S[kt][8 * s2 + 5]); p.w = pk_bf16(S[kt][8 * s2 + 6], S[kt][8 * s2 + 7]);
                    const auto sw0 = __builtin_amdgcn_permlane32_swap(p.x, p.z, false, false); p.x = sw0[0]; p.z = sw0[1];
                    const auto sw1 = __builtin_amdgcn_permlane32_swap(p.y, p.w, false, false); p.y = sw1[0]; p.w = sw1[1];
                    xs[s2] = __builtin_bit_cast(bf16x8, p);
                }
                keep = MFMA32(qf[kt & 1][0], xs[0], keep);
                send = MFMA32(qf[kt & 1][2], xs[0], send);
                keep = MFMA32(qf[kt & 1][1], xs[1], keep);
                send = MFMA32(qf[kt & 1][3], xs[1], send);
            }
        }
        { LAS f32x4* xp = (LAS f32x4*)(lds + XS + v * 4096) + lane;
#pragma unroll
          for (int g = 0; g < 4; ++g) xp[g * 64] = (f32x4){send[4 * g], send[4 * g + 1], send[4 * g + 2], send[4 * g + 3]}; }
        if (v >= 4 && n > 0) SCAN_FLUSH(n - 1);
        __syncthreads();
        const unsigned blk = (lane >> 4) & 1, q4 = (lane & 15) >> 2, p4 = lane & 3;
        const unsigned trow = (8u * h + q4) * 256u + 8u * (p4 & 1), lowch = 2u * blk + (p4 >> 1);
        const unsigned xt0 = ((q4 << 2) | (2u * h)), xt1 = xt0 | 1u;
#define TRA(base, ks, c, t) tr4((base) + ((c) >> 2) * 16384 + (ks) * 4096 + (t) * 1024 + trow + 16u * (((4u * ((c) & 3u)) + lowch) ^ ((t) ? xt1 : xt0)))
#define TRF(base, ks, c) __builtin_shufflevector(TRA(base, ks, c, 0), TRA(base, ks, c, 1), 0, 1, 2, 3, 4, 5, 6, 7)
        bf16x8 vb[4];
#pragma unroll
        for (int ks = 0; ks < 4; ++ks) { const LAS unsigned char* vl = lds + VS + (8 * h + q4) * VP + blk * 32 + p4 * 8 + et * 64 + ks * (16 * VP);
            vb[ks] = __builtin_shufflevector(tr4(vl), tr4(vl + 4 * VP), 0, 1, 2, 3, 4, 5, 6, 7); }
        f32x4 xv[4];
        { const LAS f32x4* xp = (const LAS f32x4*)(lds + XS + (v ^ 4) * 4096) + lane;
#pragma unroll
          for (int g = 0; g < 4; ++g) xv[g] = xp[g * 64]; }
        {
            bf16x8 kf[2][4];
            const int c0 = (kh * (DK / 2)) >> 5;
#pragma unroll
            for (int ks = 0; ks < 4; ++ks) kf[0][ks] = TRF(lds + KS, ks, c0);
#pragma unroll
            for (int kt = 0; kt < NT; ++kt) {
                if (kt + 1 < NT) {
#pragma unroll
                    for (int ks = 0; ks < 4; ++ks) kf[(kt + 1) & 1][ks] = TRF(lds + KS, ks, c0 + kt + 1);
                }
#pragma unroll
                for (int ks = 0; ks < 4; ++ks) S[kt] = MFMA32(kf[kt & 1][ks], vb[ks], S[kt]);
            }
        }
#pragma unroll
        for (int g = 0; g < 4; ++g) { keep[4 * g] += xv[g][0]; keep[4 * g + 1] += xv[g][1]; keep[4 * g + 2] += xv[g][2]; keep[4 * g + 3] += xv[g][3]; }
        {
            bf16x8 pa[4];
#pragma unroll
            for (int s = 0; s < 4; ++s) if (s < 2 * (kh + 1)) pa[s] = *(const LAS bf16x8*)(lds + PS + (32 * kh + r) * 144 + (16 * s + 8 * h) * 2);
#pragma unroll
            for (int s = 0; s < 4; ++s) if (s < 2 * (kh + 1)) keep = MFMA32(pa[s], vb[s], keep);
        }
#pragma unroll
        for (int kt = 0; kt < NT; ++kt) {
            if (GLA) {
                const LAS float* gp = (const LAS float*)(lds + GS) + kh * (DK / 2) + 32 * kt + 4 * h;
#pragma unroll
                for (int g = 0; g < 4; ++g) { const f32x4 gv = *(const LAS f32x4*)(gp + 8 * g); S[kt][4 * g] *= gv[0]; S[kt][4 * g + 1] *= gv[1]; S[kt][4 * g + 2] *= gv[2]; S[kt][4 * g + 3] *= gv[3]; }
            } else {
#pragma unroll
                for (int i = 0; i < 16; ++i) S[kt][i] *= g64;
            }
        }
        { LAS bf16_t* op = (LAS bf16_t*)(lds + OS);
#pragma unroll
          for (int i = 0; i < 16; ++i) { const int row = 32 * kh + (i & 3) + 8 * (i >> 2) + 4 * h; op[row * 136 + 32 * et + r] = (bf16_t)(pk_bf16(keep[i], 0.f) & 0xffffu); } }
#undef TRA
#undef TRF
#undef ROWA
        __syncthreads();
    }
    if (v >= 4) SCAN_FLUSH(NCHUNK - 1);
    __syncthreads();
}

#define XB_TMO      128
#define XB_XCNT(j)  (256  + 64 * (j))
#define XB_XSUB(j)  (1280 + 64 * (j))
#define XB_XGEN(j)  (2304 + 64 * (j))
#define XB_TOP      3328
#define XB_TOPGEN   3392
#define XCD_BAR_WORDS 3456
#define XB_SPIN_CAP (1u << 20)
DI unsigned xb_ld(unsigned* p)              { return __hip_atomic_load(p, __ATOMIC_RELAXED, __HIP_MEMORY_SCOPE_AGENT); }
DI unsigned xb_add(unsigned* p, unsigned v) { return __hip_atomic_fetch_add(p, v, __ATOMIC_RELAXED, __HIP_MEMORY_SCOPE_AGENT); }
DI unsigned xb_xcc_id() { return (unsigned)__builtin_amdgcn_s_getreg((3 << 11) | 20) & 0xFu; }
#define XB_SPIN(cond, bar) do { unsigned _sp = 0; while (cond) { __builtin_amdgcn_s_sleep(1); \
    if ((++_sp & 255u) == 0u) { if (xb_ld(&(bar)[XB_TMO])) break; if (_sp > XB_SPIN_CAP) { atomicAdd(&(bar)[XB_TMO], 1u); break; } } } } while (0)
struct XcdBarrier { unsigned* bar; unsigned x; volatile LAS unsigned* st; };
DI XcdBarrier xcd_barrier_post(unsigned* bar, volatile LAS unsigned* st) {
    XcdBarrier b; b.bar = bar; b.x = xb_xcc_id(); b.st = st;
    if (threadIdx.x == 0) (void)xb_add(&bar[XB_XCNT(b.x)], 1u);
    return b;
}
DI void xcd_barrier_complete(unsigned* bar, unsigned x, unsigned& nloc, unsigned& nx) {
    const unsigned G = gridDim.x * gridDim.y * gridDim.z;
    unsigned sum, cnt, mine, sp = 0u;
    for (;;) {
        sum = 0u; cnt = 0u; mine = 0u;
#pragma unroll
        for (unsigned j = 0; j < 16; ++j) { const unsigned c = xb_ld(&bar[XB_XCNT(j)]); sum += c; cnt += (c > 0u) ? 1u : 0u; mine = (j == x) ? c : mine; }
        if (sum == G) break;
        __builtin_amdgcn_s_sleep(1);
        if ((++sp & 255u) == 0u) { if (xb_ld(&bar[XB_TMO])) break; if (sp > XB_SPIN_CAP) { atomicAdd(&bar[XB_TMO], 1u); break; } }
    }
    nloc = mine > 0u ? mine : 1u; nx = cnt > 0u ? cnt : 1u;
}
DI void xcd_barrier(const XcdBarrier& b) {
    asm volatile("s_waitcnt vmcnt(0)" ::: "memory");
    __syncthreads();
    if (threadIdx.x == 0) {
        unsigned* bar = b.bar;
        __builtin_amdgcn_s_waitcnt(0);
        unsigned nloc = b.st[0], nx = b.st[1];
        if (nloc == 0u) { xcd_barrier_complete(bar, b.x, nloc, nx); b.st[0] = nloc; b.st[1] = nx; }
        const unsigned old = xb_add(&bar[XB_XSUB(b.x)], 1u);
        const unsigned gen = old / nloc;
        if (old + 1u == (gen + 1u) * nloc) {
            __builtin_amdgcn_fence(__ATOMIC_RELEASE, "agent");
            asm volatile("s_waitcnt vmcnt(0)" ::: "memory");
            const unsigned og = xb_add(&bar[XB_TOP], 1u);
            const unsigned tg = og / nx;
            if (og + 1u == (tg + 1u) * nx) xb_add(&bar[XB_TOPGEN], 1u);
            else XB_SPIN(xb_ld(&bar[XB_TOPGEN]) == tg, bar);
            __builtin_amdgcn_fence(__ATOMIC_ACQUIRE, "agent");
            xb_add(&bar[XB_XGEN(b.x)], 1u);
            asm volatile("s_waitcnt vmcnt(0)" ::: "memory");
        } else {
            XB_SPIN(xb_ld(&bar[XB_XGEN(b.x)]) == gen, bar);
            __builtin_amdgcn_fence(__ATOMIC_ACQUIRE, "agent");
            asm volatile("s_waitcnt vmcnt(0)" ::: "memory");
        }
    }
    __syncthreads();
}
constexpr int MISC_OFF = LDS_BYTES - 256;

struct Args { const float* in[12]; float* out; unsigned char* ws; int ph_lo, ph_hi; };
#ifndef MK_PROBE
#define MK_PROBE 0
#endif
#ifndef MK_STAGGER
#define MK_STAGGER 0
#endif

DI float wave_sum(float v) {
#pragma unroll
    for (int o = 1; o < 64; o <<= 1) v += __shfl_xor(v, o);
    return v;
}
DI void transpose_item(const float* W, int N, bf16_t* WT, int dpitch, int koff, int k0, int scol0, int drow0, LAS float* scr, int lane) {
#pragma unroll 8
    for (int i = 0; i < 32; ++i) { const int kk = 2 * i + (lane >> 5); scr[kk * 33 + (lane & 31)] = W[(size_t)(k0 + kk) * N + scol0 + (lane & 31)]; }
    asm volatile("s_waitcnt lgkmcnt(0)" ::: "memory");
    const int c = lane & 7;
#pragma unroll
    for (int j = 0; j < 4; ++j) { const int n = (lane >> 3) + 8 * j; const LAS float* s = scr + (8 * c) * 33 + n;
        u32x4 o; o.x = pk_bf16(s[0 * 33], s[1 * 33]); o.y = pk_bf16(s[2 * 33], s[3 * 33]); o.z = pk_bf16(s[4 * 33], s[5 * 33]); o.w = pk_bf16(s[6 * 33], s[7 * 33]);
        *(u32x4*)(WT + (size_t)(drow0 + n) * dpitch + koff + k0 + 8 * c) = o; }
    asm volatile("s_waitcnt lgkmcnt(0)" ::: "memory");
}

__global__ void __launch_bounds__(512, 2) mk_fwd(Args a) {
    extern __shared__ __attribute__((aligned(16))) unsigned char lds_raw[];
    LAS unsigned char* lds = (LAS unsigned char*)lds_raw;
    unsigned char* ws = a.ws;
    const float* x = a.in[0]; const float* meta = a.in[1]; const float* norm_gain = a.in[2]; const float* w_in = a.in[3];
    const float* w_gate_up = a.in[4]; const float* b_gate = a.in[5]; const float* ret_gain = a.in[6]; const float* gla_gain = a.in[7];
    const float* w_br = a.in[8]; const float* w_bg = a.in[9]; const float* w_out = a.in[10]; const float* fgain = a.in[11];
    bf16_t* srg = (bf16_t*)a.out;
#if MK_N_LAUNCHES == 1
    { volatile LAS unsigned* misc = (volatile LAS unsigned*)(lds + MISC_OFF); if (threadIdx.x < 64) misc[threadIdx.x] = 0u; }
    __syncthreads();
    const XcdBarrier xbar = xcd_barrier_post((unsigned*)(ws + WS_CTL), (volatile LAS unsigned*)(lds + MISC_OFF));
#define GRID_SYNC(k) do { if (a.ph_hi > 64) cg::this_grid().sync(); else xcd_barrier(xbar); } while (0)
#else
#define GRID_SYNC(k) do {} while (0)
#endif
#define PH_BEGIN(k) if (a.ph_lo <= (k) && (k) < a.ph_hi) { \
        int bxo = blockIdx.x, Go = gridDim.x, tid = threadIdx.x; asm volatile("" : "+s"(bxo), "+s"(Go), "+v"(tid)); \
        const int lane = tid & 63, wave = __builtin_amdgcn_readfirstlane(tid >> 6), G = Go, bx = bxo; \
        const int vcu = (G % 8 == 0) ? (bx % 8) * (G / 8) + bx / 8 : bx; (void)lane; (void)wave; (void)vcu;
#define PH_END(k) if ((k) + 1 < a.ph_hi) GRID_SYNC(k); }
    {
        PH_BEGIN(0)
          for (int rep = 0; rep < (MK_PROBE == 3 ? 2 : 1); ++rep) {
            const int gw = vcu * 8 + wave, NGW = G * 8;
            const size_t gt = (size_t)vcu * 512 + tid, NGT = (size_t)G * 512;
            { u32x4* z = (u32x4*)(ws + WS_ROWSS); const size_t nz = (WS_ROPE - WS_ROWSS) / 16; for (size_t i = gt; i < nz; i += NGT) z[i] = (u32x4){0u, 0u, 0u, 0u}; }
            LAS float* scr = (LAS float*)(lds + wave * 16384);
            constexpr int I1 = 16 * 256, I1B = 16 * 96, I3R = 32 * 32, I3G = 16 * 32, I4 = 16 * 32;
            for (int it = gw; it < I1 + I1B + I3R + I3G + I4; it += NGW) {
                int q = it;
                if (q < I1) { const int kb = q / 256, nb = q % 256, n0 = 32 * nb; const int sc = n0 < 4096 ? n0 : (n0 < 6144 ? n0 + 2048 : n0 + 3088);
                    transpose_item(w_in, IN_COLS, (bf16_t*)(ws + WS_BT1), 1024, 0, 64 * kb, sc, n0, scr, lane); continue; } q -= I1;
                if (q < I1B) { const int kb = q / 96, nb = q % 96, n0 = 32 * nb; const int sc = n0 < 2048 ? n0 + 4096 : n0 + 6144;
                    transpose_item(w_in, IN_COLS, (bf16_t*)(ws + WS_BT1B), 1024, 0, 64 * kb, sc, n0, scr, lane); continue; } q -= I1B;
                if (q < I3R) { const int kb = q / 32, nb = q % 32; transpose_item(w_br, 1024, (bf16_t*)(ws + WS_BT3), 3072, 0, 64 * kb, 32 * nb, 32 * nb, scr, lane); continue; } q -= I3R;
                if (q < I3G) { const int kb = q / 32, nb = q % 32; transpose_item(w_bg, 1024, (bf16_t*)(ws + WS_BT3), 3072, 2048, 64 * kb, 32 * nb, 32 * nb, scr, lane); continue; } q -= I3G;
                { const int kb = q / 32, nb = q % 32; transpose_item(w_out, 1024, (bf16_t*)(ws + WS_BT4), 1024, 0, 64 * kb, 32 * nb, 32 * nb, scr, lane); }
            }
            for (size_t i = gt; i < (size_t)512 * 128; i += NGT) { const int n = (int)(i >> 7), k0 = (int)(i & 127) * 8; float up[16];
#pragma unroll
                for (int rr = 0; rr < 16; ++rr) up[rr] = w_gate_up[rr * 512 + n];
                float o[8];
#pragma unroll
                for (int j = 0; j < 8; ++j) { const float* wr_ = w_in + (size_t)(k0 + j) * IN_COLS + 9216; float s = 0.f;
#pragma unroll
                    for (int rr = 0; rr < 16; ++rr) s += wr_[rr] * up[rr];
                    o[j] = s; }
                u32x4 w; w.x = pk_bf16(o[0], o[1]); w.y = pk_bf16(o[2], o[3]); w.z = pk_bf16(o[4], o[5]); w.w = pk_bf16(o[6], o[7]);
                *(u32x4*)((bf16_t*)(ws + WS_BT1) + (size_t)(8192 + n) * 1024 + k0) = w; }
            if (gt < 128) { const int d = (int)gt; double pw = 1.0, bs = 0.9305720409296989;
                for (int e = d; e; e >>= 1) { if (e & 1) pw *= bs; bs *= bs; }
                const float invf = (float)pw; const double c = (double)invf * 0.15915494309189535;
                const float chi = __uint_as_float(__float_as_uint((float)c) & 0xFFFFC000u); const float clo = (float)(c - (double)chi);
                ((f32x2*)(ws + WS_ROPE))[d] = (f32x2){chi, clo}; }
            bf16_t* U = (bf16_t*)(ws + WS_U);
            for (int m = gw; m < ROWS; m += NGW) {
                const int b = m / LP, p = m - b * LP;
                unsigned long long* o8 = (unsigned long long*)(U + (size_t)m * D) + lane;
                if (p < PADF) {
#pragma unroll
                    for (int j = 0; j < 4; ++j) o8[64 * j] = 0ull;
                    continue; }
                const float* src = p < 64 ? meta + (size_t)(p - PADF) * D : x + ((size_t)b * SEQ + (p - 64)) * D;
                const f32x4* xr = (const f32x4*)src + lane; const f32x4* gr = (const f32x4*)norm_gain + lane;
                f32x4 vv[4]; float s = 0.f;
#pragma unroll
                for (int j = 0; j < 4; ++j) { vv[j] = xr[64 * j]; s += (vv[j].x * vv[j].x + vv[j].y * vv[j].y) + (vv[j].z * vv[j].z + vv[j].w * vv[j].w); }
                const float rstd = 1.0f / sqrtf(wave_sum(s) * (1.0f / D) + EPS);
#pragma unroll
                for (int j = 0; j < 4; ++j) { const f32x4 gg = gr[64 * j]; const f32x4 y = vv[j] * rstd * gg;
                    o8[64 * j] = (unsigned long long)pk_bf16(y.x, y.y) | ((unsigned long long)pk_bf16(y.z, y.w) << 32); }
            }
          }
        PH_END(0)
        PH_BEGIN(1)
          for (int rep = 0; rep < (MK_PROBE == 1 ? 2 : 1); ++rep) {
            pg8::Gemm g{(const bf16_t*)(ws + WS_U), (const bf16_t*)(ws + WS_BT1), ROWS, N1, 1024, 0}; pg8::P1Order S; S.init(Go, bxo);
            EpiProj E{ws, srg, b_gate, 0};
            pg8::gemm_phase<EpiProj, pg8::P1Order>(lds, g, S, E, tid, MK_STAGGER);
          }
#if MK_PROBE == 5
            { pg8::Gemm g{(const bf16_t*)(ws + WS_U), (const bf16_t*)(ws + WS_BT1), ROWS, N1, 1024, 0}; pg8::StaticOrder S; S.init(ROWS, N1, Go, bxo);
              int ns = 1; asm volatile("" : "+s"(ns)); EpiProj E{ws, srg, b_gate, ns}; pg8::gemm_phase<EpiProj, pg8::StaticOrder>(lds, g, S, E, tid, MK_STAGGER); }
#endif
#if MK_PROBE == 4
            { pg8::Gemm g{(const bf16_t*)(ws + WS_U), (const bf16_t*)(ws + WS_BT1), ROWS, N1, 1024, 0}; pg8::StaticOrder S; S.init(ROWS, N1, Go, bxo);
              EpiDry E{}; pg8::gemm_phase<EpiDry, pg8::StaticOrder>(lds, g, S, E, tid, MK_STAGGER); }
#endif
        PH_END(1)
#define SCAN_BODY(DRY, MASK) do { \
            const int xcd = bxo & 7, j = bxo >> 3; \
            float* stats = (float*)(ws + WS_STATS); \
            if (G == 256 && j < 16 && ((MASK) & 1)) { \
                const int u = xcd * 16 + j, b = u >> 4, hh = (u >> 2) & 3, es = u & 3; \
                const size_t r0 = (size_t)b * LP; \
                const float g64 = exp2f(64.0f * __log2f(1.0f - exp2f(-5.0f - (float)hh))); \
                scan_unit<256, false>(lds, (const bf16_t*)(ws + WS_RQ) + r0 * 1024 + hh * 256, (const bf16_t*)(ws + WS_RK) + r0 * 1024 + hh * 256, \
                                      (bf16_t*)(ws + WS_RV) + r0 * 2048 + hh * 512 + es * 128, nullptr, stats + r0 * 48 + (hh * 4 + es) * 2, 1024, 2048, g64, tid, DRY); \
            } else if (G == 256 && j >= 16 && j < 24 && ((MASK) & 2)) { \
                const int u = xcd * 8 + (j - 16), b = u >> 3, hh = (u >> 1) & 3, es = u & 1; \
                const size_t r0 = (size_t)b * LP; \
                scan_unit<128, true>(lds, (const bf16_t*)(ws + WS_GQ) + r0 * 512 + hh * 128, (const bf16_t*)(ws + WS_GK) + r0 * 512 + hh * 128, \
                                     (bf16_t*)(ws + WS_GV) + r0 * 1024 + hh * 256 + es * 128, (const bf16_t*)(ws + WS_LA) + r0 * 512 + hh * 128, stats + r0 * 48 + (16 + hh * 2 + es) * 2, 512, 1024, 1.0f, tid, DRY); \
            } } while (0)
#if MK_PROBE == 2 || MK_PROBE == 6 || MK_PROBE == 7
        PH_BEGIN(2)
            int dry = 1, msk = (MK_PROBE == 2 ? 3 : (MK_PROBE == 6 ? 1 : 2)); asm volatile("" : "+s"(dry), "+s"(msk));
            SCAN_BODY(dry, msk);
        }
#endif
        PH_BEGIN(2)
            int dry = 0; asm volatile("" : "+s"(dry));
            SCAN_BODY(dry, 3);
            {
                const int xcd = bxo & 7, j = bxo >> 3; int sstart = 0, scount = 0;
                if (G == 256 && j >= 24) { const int k = xcd * 8 + (j - 24); sstart = 16 * k; scount = 16; }
                else if (G == 256 && j >= 16) { const int k = xcd * 8 + (j - 16); if (k < 52) { sstart = 1024 + k; scount = 1; } }
                if (scount > 0) {
                    pg8::Gemm g{(const bf16_t*)(ws + WS_U), (const bf16_t*)(ws + WS_BT1), ROWS, N1, 1024, 0}; pg8::SideOrder S{sstart, scount};
                    EpiProj E{ws, srg, b_gate, 0};
                    pg8::gemm_phase<EpiProj, pg8::SideOrder>(lds, g, S, E, tid, 0);
                }
            }
        PH_END(2)
        PH_BEGIN(3)
            static_assert(WS_BT1B == WS_BT1 + (size_t)N1 * 1024 * 2, "gate weights follow the projection weights: one fused [N][K] copy");
            if (G == 256) {
            const int pm = bxo;
            const size_t prow0 = (size_t)((pm >> 5) * LP + 64 + (pm & 31) * 256);
            bf16_t* mhome = (bf16_t*)(ws + WS_RV) + prow0 * 2048;
            bf16_t* yb = mhome + 256 * 1024;
            {
                pg8::Gemm g{(const bf16_t*)(ws + WS_U), (const bf16_t*)(ws + WS_BT1), CROWS, N1 + N1B, 1024, 1};
                pg8::P3Order S{pm, ((bxo >> 3) & 7) >> 1};
                EpiP3 E{EpiProj{ws, srg, b_gate, 0}, EpiGate{ws, ret_gain, gla_gain, (LAS float*)(lds + SSL_OFF)}};
                pg8::gemm_phase<EpiP3, pg8::P3Order>(lds, g, S, E, tid, 0);
            }
            if (wave == 0) { __builtin_amdgcn_fence(__ATOMIC_ACQUIRE, "agent"); asm volatile("s_waitcnt vmcnt(0)" ::: "memory"); }
            __syncthreads();
            {
                pg8::Gemm g{(const bf16_t*)(ws + WS_RQ), (const bf16_t*)(ws + WS_BT3), CROWS, 1024, 3072, 0}; pg8::PanelOrder S{pm, 0};
                EpiMerge E{srg, mhome};
                pg8::gemm_phase<EpiMerge, pg8::PanelOrder>(lds, g, S, E, tid, 0);
            }
            if (wave == 0) { __builtin_amdgcn_fence(__ATOMIC_ACQUIRE, "agent"); asm volatile("s_waitcnt vmcnt(0)" ::: "memory"); }
            __syncthreads();
            LAS float* ssl = (LAS float*)(lds + SSL_OFF);
            {
                pg8::Gemm g{(const bf16_t*)mhome, (const bf16_t*)(ws + WS_BT4), 256, 1024, 1024, 0}; pg8::PanelOrder S{pm, 2};
                EpiOut E{x, yb, ssl};
                pg8::gemm_phase<EpiOut, pg8::PanelOrder>(lds, g, S, E, tid, 0);
            }
            __syncthreads();
            for (int r0 = wave * 32; r0 < wave * 32 + 32; r0 += 4) {
                u32x4 vv[4][2]; float rstd[4];
#pragma unroll
                for (int q = 0; q < 4; ++q) {
                    const u32x4* yr = (const u32x4*)(yb + (size_t)(r0 + q) * D) + lane;
                    vv[q][0] = __builtin_nontemporal_load(yr); vv[q][1] = __builtin_nontemporal_load(yr + 64);
                    float ss = 0.f;
#pragma unroll
                    for (int k = 0; k < 16; ++k) ss += ssl[k * 256 + r0 + q];
                    rstd[q] = 1.0f / sqrtf(ss * (1.0f / D) + EPS);
                }
#pragma unroll
                for (int q = 0; q < 4; ++q)
#pragma unroll
                    for (int hh = 0; hh < 2; ++hh) {
                        const int e0 = hh * 512 + lane * 8;
                        const f32x4 g0 = *(const f32x4*)(fgain + e0), g1 = *(const f32x4*)(fgain + e0 + 4);
                        const u32x4 w = vv[q][hh];
                        const f32x4 o0 = (f32x4){bf_lo(w.x), bf_hi(w.x), bf_lo(w.y), bf_hi(w.y)} * rstd[q] * g0, o1 = (f32x4){bf_lo(w.z), bf_hi(w.z), bf_lo(w.w), bf_hi(w.w)} * rstd[q] * g1;
                        float* orow = a.out + ((size_t)pm * 256 + r0 + q) * D + e0;
                        *(f32x4*)orow = o0; *(f32x4*)(orow + 4) = o1;
                    }
            }
            }
        PH_END(3)
    }
}

constexpr int N_PHASES = 4;
extern "C" void kernel_launch(void* const* d_in, const int* in_sizes, int n_in, void* d_out, int out_size, void* d_ws, size_t ws_size, hipStream_t stream) {
    static int grid = 0;
    if (grid == 0) {
        if (n_in != 12 || in_sizes[0] != CROWS * D || out_size != CROWS * D || ws_size < WS_END) {
            fprintf(stderr, "kernel_launch: unexpected shapes (n_in %d, in0 %d, out %d, ws %zu; need ws >= %zu); nothing launched\n", n_in, n_in > 0 ? in_sizes[0] : -1, out_size, ws_size, (size_t)WS_END); grid = -1; return; }
        int dev = 0, cus = 0, per_cu = 0;
        if (hipGetDevice(&dev) != hipSuccess || hipDeviceGetAttribute(&cus, hipDeviceAttributeMultiprocessorCount, dev) != hipSuccess) { fprintf(stderr, "kernel_launch: device query failed\n"); grid = -1; return; }
        if (hipFuncSetAttribute((const void*)mk_fwd, hipFuncAttributeMaxDynamicSharedMemorySize, LDS_BYTES) != hipSuccess) { fprintf(stderr, "kernel_launch: hipFuncSetAttribute failed\n"); grid = -1; return; }
        if (hipOccupancyMaxActiveBlocksPerMultiprocessor(&per_cu, (const void*)mk_fwd, 512, LDS_BYTES) != hipSuccess || per_cu < 1) { fprintf(stderr, "kernel_launch: occupancy query says %d blocks per CU\n", per_cu); (void)hipGetLastError(); grid = -1; return; }
        grid = cus;
        if (grid != 256) fprintf(stderr, "kernel_launch: note: %d CUs (the scan phase is laid out for 256)\n", grid);
    }
    if (grid < 0) return;
    Args a{};
    for (int i = 0; i < 12; ++i) a.in[i] = (const float*)d_in[i];
    a.out = (float*)d_out; a.ws = (unsigned char*)d_ws;
#if MK_N_LAUNCHES == 1
    if (hipMemsetAsync((char*)d_ws + WS_CTL, 0, 65536, stream) != hipSuccess) { fprintf(stderr, "kernel_launch: memset of the control words failed\n"); return; }
    a.ph_lo = 0; a.ph_hi = N_PHASES;
    void* args[] = {&a};
    hipError_t e = hipLaunchCooperativeKernel((const void*)mk_fwd, dim3(grid), dim3(512), args, LDS_BYTES, stream);
    if (e != hipSuccess) fprintf(stderr, "kernel_launch: cooperative launch failed: %s (grid %d)\n", hipGetErrorString(e), grid);
#else
    for (int p = 0; p < N_PHASES; ++p) {
        a.ph_lo = p; a.ph_hi = p + 1;
        hipLaunchKernelGGL(mk_fwd, dim3(grid), dim3(512), LDS_BYTES, stream, a);
    }
#endif
}
```

```cpp
#include <hip/hip_runtime.h>
#include <hip/hip_cooperative_groups.h>
#include <cstdio>
#include <cstdint>
namespace cg = cooperative_groups;

#ifndef MK_N_LAUNCHES
#define MK_N_LAUNCHES 1
#endif

#define LAS __attribute__((address_space(3)))
#define DI __device__ __forceinline__
typedef unsigned short bf16_t;
typedef short bf16x8 __attribute__((ext_vector_type(8)));
typedef short s16x4 __attribute__((ext_vector_type(4)));
typedef float f32x4 __attribute__((ext_vector_type(4)));
typedef float f32x2 __attribute__((ext_vector_type(2)));
typedef float f32x16 __attribute__((ext_vector_type(16)));
typedef unsigned u32x4 __attribute__((ext_vector_type(4)));
typedef unsigned u32x2 __attribute__((ext_vector_type(2)));
typedef __bf16 bf16x2_t __attribute__((ext_vector_type(2)));

constexpr int D = 1024, NB = 8, SEQ = 8192, NMETA = 16, LTOK = SEQ + NMETA;
constexpr int PADF = 48, LP = LTOK + PADF;
constexpr int ROWS = NB * LP;
constexpr int CROWS = NB * SEQ;
constexpr int IN_COLS = 11280;
constexpr int NCHUNK = LP / 64;
constexpr float EPS = 1e-6f;
constexpr int N1 = 8704, N1B = 3072;

constexpr size_t WS_CTL = 0;
constexpr size_t WS_STATS = 65536;
constexpr size_t WS_ROWSS = WS_STATS + (size_t)ROWS * 192;
constexpr size_t WS_ROPE = WS_ROWSS + (size_t)CROWS * 4;
constexpr size_t WS_BT1 = WS_ROPE + (size_t)LTOK * 128 * 8;
constexpr size_t WS_BT1B = WS_BT1 + (size_t)N1 * 1024 * 2;
constexpr size_t WS_BT3 = WS_BT1B + (size_t)N1B * 1024 * 2;
constexpr size_t WS_BT4 = WS_BT3 + (size_t)1024 * 3072 * 2;
constexpr size_t WS_U = WS_BT4 + (size_t)1024 * 1024 * 2;
constexpr size_t WS_RQ = WS_U + (size_t)ROWS * 2048;
constexpr size_t WS_RK = WS_RQ + (size_t)ROWS * 2048;
constexpr size_t WS_GQ = WS_RK + (size_t)ROWS * 2048;
constexpr size_t WS_GK = WS_GQ + (size_t)ROWS * 1024;
constexpr size_t WS_LA = WS_GK + (size_t)ROWS * 1024;
constexpr size_t WS_RV = WS_LA + (size_t)ROWS * 1024;
constexpr size_t WS_GV = WS_RV + (size_t)ROWS * 4096;
constexpr size_t WS_END = WS_GV + (size_t)ROWS * 2048;
static_assert(WS_END <= (size_t)1073741824, "workspace map exceeds 4x the largest tensor");
static_assert((size_t)CROWS * 3072 * 2 <= WS_RV - WS_RQ, "ACAT overlay");

constexpr int LDS_BYTES = 155648;
constexpr int SSL_OFF = 131072;

DI unsigned pk_bf16(float lo, float hi) { f32x2 v = {lo, hi}; bf16x2_t b = __builtin_convertvector(v, bf16x2_t); return __builtin_bit_cast(unsigned, b); }
DI float bf_lo(unsigned w) { return __uint_as_float(w << 16); }
DI float bf_hi(unsigned w) { return __uint_as_float(w & 0xffff0000u); }
DI float sigmoidf_(float x) { return __builtin_amdgcn_rcpf(1.0f + __expf(-x)); }

namespace pg8 {
constexpr int BM = 256, BK = 64, HALF = 128, HTB = HALF * BK * 2, STAGE_BYTES = 8 * HTB, NXCD = 8, WGM = 8;
__host__ __device__ __forceinline__ int lds_byte(int r, int c) { const int st = (r >> 4) * 2 + (c >> 5), rr = r & 15, cc = c & 31, ob = rr * 64 + cc * 2; return st * 1024 + (ob ^ (((ob >> 9) & 1) << 5)); }
__host__ __device__ __forceinline__ void stage_rc(int b, int& R, int& C) { const int st = b / 1024, sb = b % 1024, swz = sb ^ (((sb >> 9) & 1) << 5); R = (st >> 1) * 16 + swz / 64; C = (st & 1) * 32 + (swz % 64) / 2; }
__host__ __device__ __forceinline__ int perm32(int rho) { const int n = rho >> 4, i = rho & 15; return 8 * (i >> 2) + 4 * n + (i & 3); }

struct Unit { int pm, pn, am; };
struct Gemm { const bf16_t* A; const bf16_t* Bt; int M, N, K, amode; };
DI size_t a_row0(const Unit& u) { return u.am ? (size_t)((u.pm >> 5) * LP + 64 + (u.pm & 31) * 256) : (size_t)u.pm * 256; }

struct StaticOrder {
    int nM, nN, nwg, G, c, am;
    __host__ __device__ void init(int M, int N, int G_, int c_, int am_ = 0) { nM = M / BM; nN = N / BM; nwg = nM * nN; G = G_; c = c_; am = am_; }
    __host__ __device__ bool next(int i, Unit& u) const {
        const long L = (long)i * G + c; if (L >= nwg) return false;
        int wgid = (int)L; { const int q = nwg / NXCD, r = nwg % NXCD, xcd = wgid % NXCD, off = wgid / NXCD; wgid = (xcd < r ? xcd * (q + 1) : r * (q + 1) + (xcd - r) * q) + off; }
        const int nig = WGM * nN, gid = wgid / nig, fm = gid * WGM, gsz = (nM - fm) < WGM ? (nM - fm) : WGM;
        u.pm = fm + ((wgid % nig) % gsz); u.pn = (wgid % nig) / gsz; u.am = am; return true;
    }
};
constexpr int SIDE_X = 1076, SIDE_Y = SIDE_X + 768, P1_MAIN = 258 * 26, P1_TOTAL = P1_MAIN + (2048 - SIDE_Y);
static_assert(P1_TOTAL % 256 == 0, "P1 units divide evenly over 256 workgroups");
struct P1Order {
    StaticOrder in; int G, c;
    __host__ __device__ void init(int G_, int c_) { in.init(258 * 256, 26 * 256, G_, c_, 0); G = G_; c = c_; }
    __host__ __device__ bool next(int i, Unit& u) const {
        const long L = (long)i * G + c;
        if (L < P1_MAIN) { in.next(i, u); if (u.pn >= 24) u.pn += 8; return true; }
        if (L >= P1_TOTAL) return false;
        const int s_ = SIDE_Y + (int)(L - P1_MAIN); u.pm = s_ >> 3; u.pn = 24 + (s_ & 7); u.am = 1; return true;
    }
};
struct P3Order {
    StaticOrder in; int pre, sbase;
    __host__ __device__ bool next(int i, Unit& u) const {
        if (i < pre) { const int s_ = sbase + i; u.pm = s_ >> 3; u.pn = 24 + (s_ & 7); u.am = 1; return true; }
        if (in.next(i - pre, u)) { u.pn += 34; return true; }
        const int j = i - 12;
        if (j < 3) { const int s_ = sbase + j; u.pm = s_ >> 3; u.pn = 24 + (s_ & 7); u.am = 1; return true; }
        return false;
    }
};
struct PanelOrder {
    int pm;
    __host__ __device__ bool next(int i, Unit& u) const { if (i >= 4) return false; u.pm = pm; u.pn = i; u.am = 0; return true; }
};
struct SideOrder {
    int start, count;
    __host__ __device__ bool next(int i, Unit& u) const { if (i >= count) return false; const int s_ = start + i; u.pm = s_ >> 3; u.pn = 24 + (s_ & 7); u.am = 1; return true; }
};

template <class Epi, class Sched>
DI void gemm_phase(LAS unsigned char* lds, const Gemm g, const Sched& S, const Epi& E, const int tid, const int stagger) {
    const int wid = __builtin_amdgcn_readfirstlane(tid >> 6), lane = tid & 63, wr = wid >> 2, wc = wid & 3, fr = lane & 15, fq = lane >> 4;
    const int K = g.K, nt = K / BK;
    unsigned voffA[2], voffB[2];
#pragma unroll
    for (int i = 0; i < 2; ++i) { int R, C; stage_rc(tid * 16 + i * 8192, R, C); const int Rb = Epi::PERM ? ((R & ~31) + perm32(R & 31)) : R;
        voffA[i] = (unsigned)(R * K + C) * 2u; voffB[i] = (unsigned)(Rb * K + C) * 2u; }
    const size_t kstep = (size_t)(BK * 2);
    const size_t hstep = (size_t)HALF * K * 2;
    const size_t tstep = 2 * hstep;
    const size_t rowb = (size_t)K * 2;
    const unsigned ldsw = (unsigned)wid * 1024u;
    const int aoff = lds_byte(wr * 64 + fr, fq * 8), boff = lds_byte(wc * 32 + fr, fq * 8);
#define PG8_SA(b, h) (((b) * 2 + (h)) * HTB)
#define PG8_SB(b, h) ((4 + (b) * 2 + (h)) * HTB)
#define PG8_STAGE(bufoff, gbase, voff) do { _Pragma("unroll") for (int _i = 0; _i < 2; ++_i) \
        __builtin_amdgcn_global_load_lds((const unsigned*)((const char*)(gbase) + (voff)[_i]), (LAS unsigned*)(lds + (bufoff) + ldsw + _i * 8192), 16, 0, 0); } while (0)
#define PG8_LDA(dst, b, h) do { _Pragma("unroll") for (int m = 0; m < 4; ++m) _Pragma("unroll") for (int k = 0; k < 2; ++k) dst[m][k] = *(const LAS bf16x8*)(lds + PG8_SA(b, h) + aoff + m * 2048 + k * 1024); } while (0)
#define PG8_LDB(dst, b, h) do { _Pragma("unroll") for (int n = 0; n < 2; ++n) _Pragma("unroll") for (int k = 0; k < 2; ++k) dst[n][k] = *(const LAS bf16x8*)(lds + PG8_SB(b, h) + boff + n * 2048 + k * 1024); } while (0)
#define PG8_MMA(ai, bj, At, Bt) do { __builtin_amdgcn_s_setprio(1); _Pragma("unroll") for (int m = 0; m < 4; ++m) _Pragma("unroll") for (int n = 0; n < 2; ++n) _Pragma("unroll") for (int k = 0; k < 2; ++k) \
        acc[ai][bj][m][n] = __builtin_amdgcn_mfma_f32_16x16x32_bf16(Bt[n][k], At[m][k], acc[ai][bj][m][n], 0, 0, 0); __builtin_amdgcn_s_setprio(0); } while (0)
#define PG8_WAIT_V(n) asm volatile("s_waitcnt vmcnt(" #n ")" ::: "memory")
#define PG8_WAIT_L(n) asm volatile("s_waitcnt lgkmcnt(" #n ")" ::: "memory")
#define PG8_BAR __builtin_amdgcn_s_barrier()
#define PG8_SCHED __builtin_amdgcn_sched_barrier(0)
    Unit cur, nxt; int ui = 0;
    if (!S.next(0, cur)) return;
    if (stagger > 0) { const unsigned long long t0 = __builtin_amdgcn_s_memrealtime(); const unsigned long long tgt = (unsigned long long)((((int)blockIdx.x >> 3) >> 3) & 3) * (unsigned)stagger;
        while (__builtin_amdgcn_s_memrealtime() - t0 < tgt) __builtin_amdgcn_s_sleep(16); }
    f32x4 acc[2][2][4][2];
#pragma unroll
    for (int a = 0; a < 2; ++a)
#pragma unroll
        for (int b = 0; b < 2; ++b)
#pragma unroll
            for (int m = 0; m < 4; ++m)
#pragma unroll
                for (int n = 0; n < 2; ++n) acc[a][b][m][n] = (f32x4){0.f, 0.f, 0.f, 0.f};
    bf16x8 At[4][2], B0[2][2], B1[2][2];
    const char* cA = (const char*)g.A + a_row0(cur) * rowb; const char* cB = (const char*)g.Bt + (size_t)cur.pn * tstep;
    PG8_STAGE(PG8_SB(0, 0), cB, voffB); PG8_STAGE(PG8_SB(0, 1), cB + hstep, voffB); PG8_STAGE(PG8_SA(0, 0), cA, voffA); PG8_STAGE(PG8_SA(0, 1), cA + hstep, voffA);
    if (wr == 1) PG8_BAR;
    PG8_WAIT_V(2); PG8_BAR;
    PG8_STAGE(PG8_SB(1, 0), cB + kstep, voffB); PG8_STAGE(PG8_SA(1, 0), cA + kstep, voffA); PG8_STAGE(PG8_SB(1, 1), cB + hstep + kstep, voffB);
    PG8_WAIT_V(6); PG8_BAR;
    for (;;) {
        const bool has_next = S.next(ui + 1, nxt);
        const char* nA = has_next ? (const char*)g.A + a_row0(nxt) * rowb : cA; const char* nB = has_next ? (const char*)g.Bt + (size_t)nxt.pn * tstep : cB;
        for (int t = 0; t < nt; t += 2) {
            if constexpr (Epi::MIDK >= 0) { if (t == Epi::MIDK) E.mid(acc, cur, wr, wc, fr, fq); }
            const bool last = (t == nt - 2);
            const char* a1 = cA + (size_t)(t + 1) * kstep;
            const char* a2 = last ? nA : cA + (size_t)(t + 2) * kstep; const char* b2 = last ? nB : cB + (size_t)(t + 2) * kstep;
            const char* a3 = a2 + kstep; const char* b3 = b2 + kstep;
            PG8_LDB(B0, 0, 0); PG8_LDB(B1, 0, 1); PG8_SCHED; PG8_LDA(At, 0, 0); PG8_STAGE(PG8_SA(1, 1), a1 + hstep, voffA);
            PG8_WAIT_V(8); PG8_WAIT_L(0); PG8_BAR; PG8_MMA(0, 0, At, B0); PG8_MMA(0, 1, At, B1); PG8_BAR; PG8_SCHED;
            PG8_LDA(At, 0, 1); PG8_STAGE(PG8_SB(0, 0), b2, voffB); PG8_STAGE(PG8_SB(0, 1), b2 + hstep, voffB); PG8_STAGE(PG8_SA(0, 0), a2, voffA);
            PG8_WAIT_V(8); PG8_WAIT_L(0); PG8_BAR; PG8_MMA(1, 0, At, B0); PG8_MMA(1, 1, At, B1); PG8_BAR; PG8_SCHED;
            PG8_LDB(B0, 1, 0); PG8_LDB(B1, 1, 1); PG8_SCHED; PG8_LDA(At, 1, 0); PG8_STAGE(PG8_SA(0, 1), a2 + hstep, voffA);
            PG8_WAIT_V(8); PG8_WAIT_L(0); PG8_BAR; PG8_MMA(0, 0, At, B0); PG8_MMA(0, 1, At, B1); PG8_BAR; PG8_SCHED;
            PG8_LDA(At, 1, 1); PG8_STAGE(PG8_SB(1, 0), b3, voffB); PG8_STAGE(PG8_SB(1, 1), b3 + hstep, voffB); PG8_STAGE(PG8_SA(1, 0), a3, voffA);
            PG8_WAIT_V(8); PG8_WAIT_L(0); PG8_BAR; PG8_MMA(1, 0, At, B0); PG8_MMA(1, 1, At, B1); PG8_BAR; PG8_SCHED;
        }
        if (wr == 0) PG8_BAR;
        E(acc, cur, wr, wc, fr, fq);
        if (!has_next) break;
#pragma unroll
        for (int a = 0; a < 2; ++a)
#pragma unroll
            for (int b = 0; b < 2; ++b)
#pragma unroll
                for (int m = 0; m < 4; ++m)
#pragma unroll
                    for (int n = 0; n < 2; ++n) acc[a][b][m][n] = (f32x4){0.f, 0.f, 0.f, 0.f};
        cur = nxt; cA = nA; cB = nB; ++ui;
        if (wr == 1) PG8_BAR;
    }
    PG8_WAIT_V(0);
    PG8_BAR;
#undef PG8_SA
#undef PG8_SB
#undef PG8_STAGE
#undef PG8_LDA
#undef PG8_LDB
#undef PG8_MMA
#undef PG8_WAIT_V
#undef PG8_WAIT_L
#undef PG8_BAR
#undef PG8_SCHED
}
}

typedef f32x4 Acc[2][2][4][2];

struct EpiProj {
    static constexpr bool PERM = true; static constexpr int MIDK = -1;
    unsigned char* ws; bf16_t* srg; const float* b_gate; int nostore;
    template <int MODE> DI void run(const Acc& acc, int row0, int cl, bf16_t* base, int pitch, int colt, int head) const {
        const float lg2 = __log2f(1.0f - exp2f(-5.0f - (float)head));
        float chi[8], clo[8];
        if (MODE == 4 || MODE == 5) { const f32x4* rc = (const f32x4*)((const f32x2*)(ws + WS_ROPE) + cl); const f32x4 c0 = rc[0], c1 = rc[1], c2 = rc[2], c3 = rc[3];
            chi[0] = c0[0]; clo[0] = c0[1]; chi[1] = c0[2]; clo[1] = c0[3]; chi[2] = c1[0]; clo[2] = c1[1]; chi[3] = c1[2]; clo[3] = c1[3];
            chi[4] = c2[0]; clo[4] = c2[1]; chi[5] = c2[2]; clo[5] = c2[3]; chi[6] = c3[0]; clo[6] = c3[1]; chi[7] = c3[2]; clo[7] = c3[3]; }
#pragma unroll
        for (int ai = 0; ai < 2; ++ai)
#pragma unroll
            for (int m = 0; m < 4; ++m) {
                const int row = row0 + ai * 128 + m * 16;
                const int b = row / LP, p = row - b * LP;
                if (MODE == 2) {
                    if (p < 64) continue;
                    unsigned char* rowp = (unsigned char*)base + (size_t)(b * SEQ + p - 64) * pitch + colt + cl;
#pragma unroll
                    for (int bj = 0; bj < 2; ++bj) { const f32x4 v0 = acc[ai][bj][m][0], v1 = acc[ai][bj][m][1];
                        const float q[8] = {sigmoidf_(v0[0]), sigmoidf_(v0[1]), sigmoidf_(v0[2]), sigmoidf_(v0[3]), sigmoidf_(v1[0]), sigmoidf_(v1[1]), sigmoidf_(v1[2]), sigmoidf_(v1[3])};
                        unsigned b8[8];
#pragma unroll
                        for (int j = 0; j < 8; ++j) { const unsigned t = (unsigned)__builtin_rintf(q[j] * 255.0f); b8[j] = t < 1u ? 1u : t; }
                        u32x2 w; w.x = b8[0] | (b8[1] << 8) | (b8[2] << 16) | (b8[3] << 24); w.y = b8[4] | (b8[5] << 8) | (b8[6] << 16) | (b8[7] << 24);
                        if (nostore) asm volatile("" :: "v"(w)); else __builtin_nontemporal_store(w, (u32x2*)(rowp + bj * 128)); }
                } else if (MODE == 4 || MODE == 5) {
                    bf16_t* rowp = base + (size_t)row * pitch + colt + cl;
                    const int t = p >= PADF ? p - PADF : 0;
                    const float tf = (float)t;
                    const float ic = (float)(p & 63);
                    const float sc = MODE == 4 ? exp2f(ic * lg2) : 0.0625f * exp2f(-ic * lg2);
                    const f32x4 a0 = acc[ai][0][m][0], a1 = acc[ai][0][m][1], c0 = acc[ai][1][m][0], c1 = acc[ai][1][m][1];
                    float o1[8], o2[8];
                    float cs[8], sn[8];
#pragma unroll
                    for (int j = 0; j < 8; ++j) { const float p0 = tf * chi[j]; const float rev = (p0 - floorf(p0)) + tf * clo[j]; cs[j] = __builtin_amdgcn_cosf(rev); sn[j] = __builtin_amdgcn_sinf(rev); }
                    const float t1[8] = {a0[0], a0[1], a0[2], a0[3], a1[0], a1[1], a1[2], a1[3]};
                    const float t2[8] = {c0[0], c0[1], c0[2], c0[3], c1[0], c1[1], c1[2], c1[3]};
#pragma unroll
                    for (int j = 0; j < 8; ++j) { o1[j] = (t1[j] * cs[j] - t2[j] * sn[j]) * sc; o2[j] = (t2[j] * cs[j] + t1[j] * sn[j]) * sc; }
                    u32x4 w1, w2;
                    w1.x = pk_bf16(o1[0], o1[1]); w1.y = pk_bf16(o1[2], o1[3]); w1.z = pk_bf16(o1[4], o1[5]); w1.w = pk_bf16(o1[6], o1[7]);
                    w2.x = pk_bf16(o2[0], o2[1]); w2.y = pk_bf16(o2[2], o2[3]); w2.z = pk_bf16(o2[4], o2[5]); w2.w = pk_bf16(o2[6], o2[7]);
                    if (nostore) { asm volatile("" :: "v"(w1), "v"(w2)); } else { __builtin_nontemporal_store(w1, (u32x4*)(rowp)); __builtin_nontemporal_store(w2, (u32x4*)(rowp + 128)); }
                } else {
                    bf16_t* rowp = base + (size_t)row * pitch + colt + cl;
#pragma unroll
                    for (int bj = 0; bj < 2; ++bj) { f32x4 v0 = acc[ai][bj][m][0], v1 = acc[ai][bj][m][1];
                        if (MODE == 1) { v0 = v0 * 0.08838834764831845f; v1 = v1 * 0.08838834764831845f; }
                        if (MODE == 3) {
                            const f32x4 g0 = *(const f32x4*)(b_gate + colt + cl + bj * 128), g1 = *(const f32x4*)(b_gate + colt + cl + bj * 128 + 4);
                            v0 = v0 + g0; v1 = v1 + g1;
#pragma unroll
                            for (int j = 0; j < 4; ++j) { v0[j] = -0.0625f * (fmaxf(-v0[j], 0.f) + __logf(1.0f + __expf(-fabsf(v0[j])))); v1[j] = -0.0625f * (fmaxf(-v1[j], 0.f) + __logf(1.0f + __expf(-fabsf(v1[j])))); }
                        }
                        u32x4 w; w.x = pk_bf16(v0[0], v0[1]); w.y = pk_bf16(v0[2], v0[3]); w.z = pk_bf16(v1[0], v1[1]); w.w = pk_bf16(v1[2], v1[3]);
                        if (nostore) asm volatile("" :: "v"(w)); else __builtin_nontemporal_store(w, (u32x4*)(rowp + bj * 128)); }
                }
            }
    }
    DI void run_decay(const Acc& acc, int row0, int cl, bf16_t* base, int colt, int lane) const {
#pragma unroll
        for (int ai = 0; ai < 2; ++ai)
#pragma unroll
            for (int bj = 0; bj < 2; ++bj) {
                const f32x4 g0 = *(const f32x4*)(b_gate + colt + cl + bj * 128), g1 = *(const f32x4*)(b_gate + colt + cl + bj * 128 + 4);
                float v[4][8];
#pragma unroll
                for (int m = 0; m < 4; ++m) {
                    const int row = row0 + ai * 128 + m * 16; const int b = row / LP, p = row - b * LP;
                    const f32x4 a0 = acc[ai][bj][m][0] + g0, a1 = acc[ai][bj][m][1] + g1;
                    const float t[8] = {a0[0], a0[1], a0[2], a0[3], a1[0], a1[1], a1[2], a1[3]};
#pragma unroll
                    for (int j = 0; j < 8; ++j) { float x = -0.0625f * (fmaxf(-t[j], 0.f) + __logf(1.0f + __expf(-fabsf(t[j])))); if (p < PADF) x = 0.f;
                        x += __int_as_float(__builtin_amdgcn_update_dpp(0, __float_as_int(x), 0x111, 0xF, 0xF, true));
                        x += __int_as_float(__builtin_amdgcn_update_dpp(0, __float_as_int(x), 0x112, 0xF, 0xF, true));
                        x += __int_as_float(__builtin_amdgcn_update_dpp(0, __float_as_int(x), 0x114, 0xF, 0xF, true));
                        x += __int_as_float(__builtin_amdgcn_update_dpp(0, __float_as_int(x), 0x118, 0xF, 0xF, true));
                        v[m][j] = x; }
                }
                const int bsrc = ((lane & 48) | 15) * 4;
#pragma unroll
                for (int m = 1; m < 4; ++m)
#pragma unroll
                    for (int j = 0; j < 8; ++j) v[m][j] += __int_as_float(__builtin_amdgcn_ds_bpermute(bsrc, __float_as_int(v[m - 1][j])));
#pragma unroll
                for (int m = 0; m < 4; ++m) {
                    const int row = row0 + ai * 128 + m * 16;
                    u32x4 w; w.x = pk_bf16(__expf(v[m][0]), __expf(v[m][1])); w.y = pk_bf16(__expf(v[m][2]), __expf(v[m][3])); w.z = pk_bf16(__expf(v[m][4]), __expf(v[m][5])); w.w = pk_bf16(__expf(v[m][6]), __expf(v[m][7]));
                    if (nostore) asm volatile("" :: "v"(w)); else __builtin_nontemporal_store(w, (u32x4*)(base + (size_t)row * 512 + colt + cl + bj * 128));
                }
            }
    }
    DI void operator()(const Acc& acc, const pg8::Unit& u, int wr, int wc, int fr, int fq) const {
        asm volatile("" : "+v"(fr), "+v"(fq));
        const int row0 = (int)pg8::a_row0(u) + wr * 64 + fr, cl = wc * 32 + 8 * fq, pn = u.pn;
        if (pn < 4)       run<4>(acc, row0, cl, (bf16_t*)(ws + WS_RQ), 1024, 256 * pn, pn);
        else if (pn < 8)  run<5>(acc, row0, cl, (bf16_t*)(ws + WS_RK), 1024, 256 * (pn - 4), pn - 4);
        else if (pn < 16) run<0>(acc, row0, cl, (bf16_t*)(ws + WS_RV), 2048, 256 * (pn - 8), 0);
        else if (pn < 18) run<1>(acc, row0, cl, (bf16_t*)(ws + WS_GQ), 512, 256 * (pn - 16), 0);
        else if (pn < 20) run<0>(acc, row0, cl, (bf16_t*)(ws + WS_GK), 512, 256 * (pn - 18), 0);
        else if (pn < 24) run<0>(acc, row0, cl, (bf16_t*)(ws + WS_GV), 1024, 256 * (pn - 20), 0);
        else if (pn < 32) run<2>(acc, row0, cl, srg, 2048, 256 * (pn - 24), 0);
        else              run_decay(acc, row0, cl, (bf16_t*)(ws + WS_LA), 256 * (pn - 32), fq * 16 + fr);
    }
};

struct EpiDry {
    static constexpr bool PERM = true; static constexpr int MIDK = -1;
    DI void operator()(const Acc& acc, const pg8::Unit& u, int wr, int wc, int fr, int fq) const {
#pragma unroll
        for (int ai = 0; ai < 2; ++ai)
#pragma unroll
            for (int bj = 0; bj < 2; ++bj)
#pragma unroll
                for (int m = 0; m < 4; ++m)
#pragma unroll
                    for (int n = 0; n < 2; ++n) asm volatile("" :: "v"(acc[ai][bj][m][n]));
    }
};
struct EpiGate {
    static constexpr bool PERM = true; static constexpr int MIDK = -1;
    unsigned char* ws; const float* ret_gain; const float* gla_gain; LAS float* tab;
    DI void operator()(const Acc& acc, const pg8::Unit& u, int wr, int wc, int fr, int fq) const {
        asm volatile("" : "+v"(fr), "+v"(fq));
        const int pn = u.pn - 34, pm = u.pm, cl = wc * 32 + 8 * fq;
        const bool ret = pn < 8;
        const int col0 = ret ? 256 * pn : 256 * (pn - 8);
        const int slot = ret ? (pn >> 1) * 4 : 16 + (pn - 8) * 2;
        const bf16_t* O = (const bf16_t*)(ws + (ret ? WS_RV : WS_GV)); const int opitch = ret ? 2048 : 1024;
        const float* gain = (ret ? ret_gain : gla_gain) + col0 + cl;
        const float invn = ret ? (1.0f / 512.0f) : (1.0f / 256.0f);
        const float* stats = (const float*)(ws + WS_STATS);
        bf16_t* acat = (bf16_t*)(ws + WS_RQ);
        const int acol = (ret ? 0 : 2048) + col0 + cl;
        const size_t prow0 = (size_t)((pm >> 5) * LP + 64 + (pm & 31) * 256), crow0 = (size_t)pm * 256;
        { const int t_ = ((wr * 4 + wc) << 6) + fq * 16 + fr;
          if (t_ < 256) { const float* sp = stats + (prow0 + t_) * 48 + slot * 2; f32x4 p = *(const f32x4*)sp; if (ret) p = p + *(const f32x4*)(sp + 4);
              const float sm = p[0] + p[2], sq = p[1] + p[3];
              const float mu = ret ? sm * invn : 0.f; const float var = sq * invn - mu * mu; const float rs = __builtin_amdgcn_rsqf(fmaxf(var, 0.f) + EPS);
              *(LAS f32x2*)(tab + 2 * t_) = (f32x2){rs, -mu * rs}; }
          asm volatile("s_waitcnt lgkmcnt(0)" ::: "memory"); __builtin_amdgcn_s_barrier(); asm volatile("" ::: "memory"); }
        f32x4 gn[2][2];
#pragma unroll
        for (int bj = 0; bj < 2; ++bj) { gn[bj][0] = *(const f32x4*)(gain + bj * 128); gn[bj][1] = *(const f32x4*)(gain + bj * 128 + 4); }
        u32x4 ov[4][2];
#define GATE_LD(g_) do { const int rr_ = ((g_) >> 2) * 128 + wr * 64 + ((g_) & 3) * 16 + fr; const bf16_t* orow = O + (prow0 + rr_) * opitch + col0 + cl; \
            ov[(g_) & 3][0] = *(const u32x4*)(orow); ov[(g_) & 3][1] = *(const u32x4*)(orow + 128); } while (0)
#pragma unroll
        for (int g = 0; g < 4; ++g) GATE_LD(g);
#pragma unroll
        for (int g = 0; g < 8; ++g) {
            const int ai = g >> 2, m = g & 3;
            const int rr = ai * 128 + wr * 64 + m * 16 + fr;
            const f32x2 ab = *(const LAS f32x2*)(tab + 2 * rr);
            bf16_t* arow = acat + (crow0 + rr) * 3072 + acol;
            u32x4 wv[2];
#pragma unroll
            for (int bj = 0; bj < 2; ++bj) {
                const u32x4 o4 = ov[g & 3][bj];
                const f32x4 v0 = acc[ai][bj][m][0], v1 = acc[ai][bj][m][1];
                const float o[8] = {bf_lo(o4.x), bf_hi(o4.x), bf_lo(o4.y), bf_hi(o4.y), bf_lo(o4.z), bf_hi(o4.z), bf_lo(o4.w), bf_hi(o4.w)};
                const float gt[8] = {v0[0], v0[1], v0[2], v0[3], v1[0], v1[1], v1[2], v1[3]};
                const float gg[8] = {gn[bj][0][0], gn[bj][0][1], gn[bj][0][2], gn[bj][0][3], gn[bj][1][0], gn[bj][1][1], gn[bj][1][2], gn[bj][1][3]};
                float r[8];
#pragma unroll
                for (int j = 0; j < 8; ++j) r[j] = (o[j] * ab.x + ab.y) * gg[j] * (gt[j] * sigmoidf_(gt[j]));
                wv[bj].x = pk_bf16(r[0], r[1]); wv[bj].y = pk_bf16(r[2], r[3]); wv[bj].z = pk_bf16(r[4], r[5]); wv[bj].w = pk_bf16(r[6], r[7]);
            }
            if (g + 4 < 8) GATE_LD(g + 4);
            *(u32x4*)(arow) = wv[0]; *(u32x4*)(arow + 128) = wv[1];
            asm volatile("" ::: "memory");
        }
#undef GATE_LD
    }
};
struct EpiP3 {
    static constexpr bool PERM = true; static constexpr int MIDK = -1;
    EpiProj a; EpiGate b;
    DI void operator()(const Acc& acc, const pg8::Unit& u, int wr, int wc, int fr, int fq) const { if (u.pn >= 34) b(acc, u, wr, wc, fr, fq); else a(acc, u, wr, wc, fr, fq); }
};
struct EpiMerge {
    static constexpr bool PERM = true; static constexpr int MIDK = 32;
    const unsigned char* srg; bf16_t* merged;
    DI void mid(Acc& acc, const pg8::Unit& u, int wr, int wc, int fr, int fq) const {
        asm volatile("" : "+v"(fr), "+v"(fq));
        const int col = 256 * u.pn + wc * 32 + 8 * fq;
#pragma unroll
        for (int ai = 0; ai < 2; ++ai) {
            u32x2 sv[4][2], gv[4][2];
#pragma unroll
            for (int m = 0; m < 4; ++m) {
                const size_t row = (size_t)u.pm * 256 + ai * 128 + wr * 64 + m * 16 + fr;
#pragma unroll
                for (int bj = 0; bj < 2; ++bj) { sv[m][bj] = *(const u32x2*)(srg + row * 2048 + col + bj * 128); gv[m][bj] = *(const u32x2*)(srg + row * 2048 + 1024 + col + bj * 128); }
            }
#pragma unroll
            for (int m = 0; m < 4; ++m)
#pragma unroll
                for (int bj = 0; bj < 2; ++bj) {
                    const u32x2 s4 = sv[m][bj], g4 = gv[m][bj];
                    float r[8];
#pragma unroll
                    for (int j = 0; j < 8; ++j) { const unsigned sw = j < 4 ? s4.x : s4.y, gw = j < 4 ? g4.x : g4.y; const int sh = 8 * (j & 3);
                        r[j] = (float)((sw >> sh) & 255u) * __builtin_amdgcn_rcpf((float)((gw >> sh) & 255u)); }
                    acc[ai][bj][m][0] = acc[ai][bj][m][0] * (f32x4){r[0], r[1], r[2], r[3]}; acc[ai][bj][m][1] = acc[ai][bj][m][1] * (f32x4){r[4], r[5], r[6], r[7]};
                }
            asm volatile("" ::: "memory");
        }
    }
    DI void operator()(const Acc& acc, const pg8::Unit& u, int wr, int wc, int fr, int fq) const {
        asm volatile("" : "+v"(fr), "+v"(fq));
        const int col = 256 * u.pn + wc * 32 + 8 * fq;
#pragma unroll
        for (int ai = 0; ai < 2; ++ai) {
            u32x2 gv[4][2];
#pragma unroll
            for (int m = 0; m < 4; ++m) {
                const size_t row = (size_t)u.pm * 256 + ai * 128 + wr * 64 + m * 16 + fr;
#pragma unroll
                for (int bj = 0; bj < 2; ++bj) gv[m][bj] = *(const u32x2*)(srg + row * 2048 + 1024 + col + bj * 128);
            }
#pragma unroll
            for (int m = 0; m < 4; ++m) {
                const size_t row = (size_t)u.pm * 256 + ai * 128 + wr * 64 + m * 16 + fr;
#pragma unroll
                for (int bj = 0; bj < 2; ++bj) {
                    const u32x2 g4 = gv[m][bj];
                    const f32x4 v0 = acc[ai][bj][m][0], v1 = acc[ai][bj][m][1];
                    const float vv[8] = {v0[0], v0[1], v0[2], v0[3], v1[0], v1[1], v1[2], v1[3]};
                    float r[8];
#pragma unroll
                    for (int j = 0; j < 8; ++j) { const unsigned gw = j < 4 ? g4.x : g4.y; r[j] = vv[j] * ((float)((gw >> (8 * (j & 3))) & 255u) * (1.0f / 255.0f)); }
                    u32x4 w; w.x = pk_bf16(r[0], r[1]); w.y = pk_bf16(r[2], r[3]); w.z = pk_bf16(r[4], r[5]); w.w = pk_bf16(r[6], r[7]);
                    *(u32x4*)(merged + row * 1024 + col + bj * 128) = w;
                }
            }
            asm volatile("" ::: "memory");
        }
    }
};

struct EpiOut {
    static constexpr bool PERM = true; static constexpr int MIDK = -1;
    const float* x; bf16_t* yb; LAS float* ssl;
    DI void operator()(const Acc& acc, const pg8::Unit& u, int wr, int wc, int fr, int fq) const {
        asm volatile("" : "+v"(fr), "+v"(fq));
        const int col = 256 * u.pn + wc * 32 + 8 * fq;
#pragma unroll
        for (int ai = 0; ai < 2; ++ai)
#pragma unroll
            for (int m = 0; m < 4; ++m) {
                const size_t row = (size_t)u.pm * 256 + ai * 128 + wr * 64 + m * 16 + fr;
                float ss = 0.f;
#pragma unroll
                for (int bj = 0; bj < 2; ++bj) {
                    const size_t o = row * 1024 + col + bj * 128;
                    const f32x4 v0 = *(const f32x4*)(x + o) + acc[ai][bj][m][0], v1 = *(const f32x4*)(x + o + 4) + acc[ai][bj][m][1];
                    ss += (v0[0] * v0[0] + v0[1] * v0[1]) + (v0[2] * v0[2] + v0[3] * v0[3]) + (v1[0] * v1[0] + v1[1] * v1[1]) + (v1[2] * v1[2] + v1[3] * v1[3]);
                    u32x4 w; w.x = pk_bf16(v0[0], v0[1]); w.y = pk_bf16(v0[2], v0[3]); w.z = pk_bf16(v1[0], v1[1]); w.w = pk_bf16(v1[2], v1[3]);
                    *(u32x4*)(yb + o) = w;
                }
                ss += __shfl_xor(ss, 16); ss += __shfl_xor(ss, 32);
                if (fq == 0) ssl[(u.pn * 4 + wc) * 256 + ai * 128 + wr * 64 + m * 16 + fr] = ss;
                asm volatile("" ::: "memory");
            }
    }
};

DI unsigned img_off(unsigned row, unsigned ch) {
    return ((ch >> 4) * 64u + row) * 256u + 16u * ((ch & 15u) ^ (((row & 3u) << 2) | ((row >> 2) & 3u)));
}
DI s16x4 tr4(const LAS unsigned char* p) { return __builtin_bit_cast(s16x4, __builtin_amdgcn_ds_read_tr16_b64_v4i16((LAS s16x4*)p)); }
DI bf16x8 tr_frag(const LAS unsigned char* base, int ks, int c, int lane) {
    const unsigned h = lane >> 5, blk = (lane >> 4) & 1, q = (lane & 15) >> 2, p = lane & 3;
    const unsigned ch = 4 * c + 2 * blk + (p >> 1), r0 = 16 * ks + 8 * h + q;
    const s16x4 lo = tr4(base + img_off(r0, ch) + 8 * (p & 1));
    const s16x4 hi = tr4(base + img_off(r0 + 4, ch) + 8 * (p & 1));
    return __builtin_shufflevector(lo, hi, 0, 1, 2, 3, 4, 5, 6, 7);
}
DI bf16x8 pack8(const f32x16& x, int s) {
    u32x4 p; p.x = pk_bf16(x[8 * s], x[8 * s + 1]); p.y = pk_bf16(x[8 * s + 2], x[8 * s + 3]); p.z = pk_bf16(x[8 * s + 4], x[8 * s + 5]); p.w = pk_bf16(x[8 * s + 6], x[8 * s + 7]);
    return __builtin_bit_cast(bf16x8, p);
}
#define MFMA32(a, b, c) __builtin_amdgcn_mfma_f32_32x32x16_bf16((a), (b), (c), 0, 0, 0)

#define SCAN_FLUSH(NN) do { const int tt = tid - 256, row = tt >> 2, qt = tt & 3; \
          const LAS u32x4* op = (const LAS u32x4*)(lds + OS + row * 272 + qt * 64); \
          const u32x4 w0 = op[0], w1 = op[1], w2 = op[2], w3 = op[3]; \
          float s_ = 0.f, ss_ = 0.f; \
          { const unsigned ww[16] = {w0.x, w0.y, w0.z, w0.w, w1.x, w1.y, w1.z, w1.w, w2.x, w2.y, w2.z, w2.w, w3.x, w3.y, w3.z, w3.w}; \
            _Pragma("unroll") for (int j = 0; j < 16; ++j) { const float a_ = bf_lo(ww[j]), b_ = bf_hi(ww[j]); s_ += a_ + b_; ss_ += a_ * a_ + b_ * b_; } } \
          s_ += __shfl_xor(s_, 1); ss_ += __shfl_xor(ss_, 1); s_ += __shfl_xor(s_, 2); ss_ += __shfl_xor(ss_, 2); \
          const size_t grow = (size_t)(NN) * 64 + row; \
          if (!dry) { if (qt == 0) *(f32x2*)(statp + grow * 48) = (f32x2){s_, ss_}; \
              u32x4* gp = (u32x4*)(Vg + grow * vp + qt * 32); gp[0] = w0; gp[1] = w1; gp[2] = w2; gp[3] = w3; } } while (0)
template <int DK, bool GLA>
DI void scan_unit(LAS unsigned char* lds, const bf16_t* Qg, const bf16_t* Kg, bf16_t* Vg, const bf16_t* LAg, float* statp, int qkp, int vp, float g64, const int tid, const int dry) {
    constexpr int NT = DK / 64;
    constexpr int NQ = DK / 64;
    constexpr int CPR = DK / 8;
    constexpr int QP = DK * 2 + 16, VP = 320;
    constexpr int QS = 0, KS = QS + 64 * QP, VS = KS + 64 * DK * 2, PS = VS + 64 * VP, XS = PS + 64 * 144, OS = XS + 32768, GS = OS + 64 * 272, END = GS + 512;
    static_assert(END <= LDS_BYTES - 256, "scan LDS map");
    const int lane0 = tid & 63, v = __builtin_amdgcn_readfirstlane(tid >> 6), et = v & 3, kh = v >> 2;
    f32x16 S[NT];
#pragma unroll
    for (int kt = 0; kt < NT; ++kt)
#pragma unroll
        for (int i = 0; i < 16; ++i) S[kt][i] = 0.f;
    u32x4 qreg[NQ], kreg[NQ], vreg[2], lreg[2];
    auto load_chunk = [&](int n) {
        const size_t row0 = (size_t)n * 64;
#pragma unroll
        for (int i = 0; i < NQ; ++i) { const int pi = tid + 512 * i, row = pi / CPR, ch = pi % CPR;
            qreg[i] = *(const u32x4*)(Qg + (row0 + row) * qkp + ch * 8); kreg[i] = *(const u32x4*)(Kg + (row0 + row) * qkp + ch * 8);
            if (GLA) lreg[i] = *(const u32x4*)(LAg + (row0 + row) * qkp + ch * 8); }
#pragma unroll
        for (int i = 0; i < 2; ++i) { const int pi = tid + 512 * i, row = pi >> 4, ch = pi & 15; vreg[i] = *(const u32x4*)(Vg + (row0 + row) * vp + ch * 8); }
    };
    load_chunk(0);
    for (int n = 0; n < NCHUNK; ++n) {
        int lane = lane0; asm volatile("" : "+v"(lane));
        const int r = lane & 31, h = lane >> 5;
        if (GLA) {
#pragma unroll
            for (int i = 0; i < 2; ++i) { const int pi = tid + 512 * i, row = pi >> 4, ch = pi & 15;
                const u32x4 w = lreg[i];
                const float e[8] = {bf_lo(w.x), bf_hi(w.x), bf_lo(w.y), bf_hi(w.y), bf_lo(w.z), bf_hi(w.z), bf_lo(w.w), bf_hi(w.w)};
                float ei[8];
#pragma unroll
                for (int j = 0; j < 8; ++j) ei[j] = __builtin_amdgcn_rcpf(e[j]);
                const u32x4 qw = qreg[i], kw = kreg[i]; u32x4 qo, ko;
                qo.x = pk_bf16(bf_lo(qw.x) * e[0], bf_hi(qw.x) * e[1]); qo.y = pk_bf16(bf_lo(qw.y) * e[2], bf_hi(qw.y) * e[3]); qo.z = pk_bf16(bf_lo(qw.z) * e[4], bf_hi(qw.z) * e[5]); qo.w = pk_bf16(bf_lo(qw.w) * e[6], bf_hi(qw.w) * e[7]);
                ko.x = pk_bf16(bf_lo(kw.x) * ei[0], bf_hi(kw.x) * ei[1]); ko.y = pk_bf16(bf_lo(kw.y) * ei[2], bf_hi(kw.y) * ei[3]); ko.z = pk_bf16(bf_lo(kw.z) * ei[4], bf_hi(kw.z) * ei[5]); ko.w = pk_bf16(bf_lo(kw.w) * ei[6], bf_hi(kw.w) * ei[7]);
                *(LAS u32x4*)(lds + QS + row * QP + ch * 16) = qo; *(LAS u32x4*)(lds + KS + img_off(row, ch)) = ko;
                if (row == 63) { LAS float* gp = (LAS float*)(lds + GS) + ch * 8; *(LAS f32x4*)gp = (f32x4){e[0], e[1], e[2], e[3]}; *(LAS f32x4*)(gp + 4) = (f32x4){e[4], e[5], e[6], e[7]}; } }
        } else {
#pragma unroll
            for (int i = 0; i < NQ; ++i) { const int pi = tid + 512 * i, row = pi / CPR, ch = pi % CPR;
                *(LAS u32x4*)(lds + QS + row * QP + ch * 16) = qreg[i]; *(LAS u32x4*)(lds + KS + img_off(row, ch)) = kreg[i]; }
        }
#pragma unroll
        for (int i = 0; i < 2; ++i) { const int pi = tid + 512 * i, row = pi >> 4, ch = pi & 15; *(LAS u32x4*)(lds + VS + row * VP + ch * 16) = vreg[i]; }
        __syncthreads();
        if (n + 1 < NCHUNK) load_chunk(n + 1);
        const unsigned rowb0 = (unsigned)r * 256u, xr = 16u * ((((unsigned)r & 3u) << 2) | (((unsigned)r >> 2) & 3u));
#define ROWA(base, rt, ch) ((base) + ((ch) >> 4) * 16384 + (rt) * 8192 + rowb0 + ((16u * ((ch) & 15u)) ^ xr))
        if (v < 3) {
            const int jt = v >> 1, it = (v + 1) >> 1;
            const LAS unsigned char* kb = lds + KS + jt * 8192 + 16 * h; const LAS unsigned char* qb = lds + QS + it * 8192 + 16 * h;
            const unsigned xh = xr ^ (16u * (unsigned)h);
#define SCA(s_) (*(const LAS bf16x8*)(kb - 16 * h + (((2 * (s_)) >> 4) * 16384) + rowb0 + ((32u * ((s_) & 7u)) ^ xh)))
#define SCB(s_) (*(const LAS bf16x8*)(lds + QS + (32 * it + r) * QP + 16 * h + 32 * (s_)))
            constexpr int NS = DK / 16;
            bf16x8 fa[4], fb[4];
#pragma unroll
            for (int s = 0; s < 4; ++s) { fa[s] = SCA(s); fb[s] = SCB(s); }
            f32x16 p;
#pragma unroll
            for (int i = 0; i < 16; ++i) p[i] = 0.f;
#pragma unroll
            for (int s = 0; s < NS; ++s) {
                p = MFMA32(fa[s & 3], fb[s & 3], p);
                if (s + 4 < NS) { fa[s & 3] = SCA(s + 4); fb[s & 3] = SCB(s + 4); }
            }
#undef SCA
#undef SCB
            const bool diag = (jt == it);
#pragma unroll
            for (int g = 0; g < 4; ++g) {
                float x[4];
#pragma unroll
                for (int j = 0; j < 4; ++j) { const int jl = 8 * g + 4 * h + j; x[j] = (!diag || r >= jl) ? p[4 * g + j] : 0.f; }
                u32x2 w; w.x = pk_bf16(x[0], x[1]); w.y = pk_bf16(x[2], x[3]);
                *(LAS u32x2*)(lds + PS + (32 * it + r) * 144 + (32 * jt + 8 * g + 4 * h) * 2) = w;
            }
        }
        f32x16 keep, send;
#pragma unroll
        for (int i = 0; i < 16; ++i) { keep[i] = 0.f; send[i] = 0.f; }
        {
            const LAS unsigned char* qown = lds + QS + (32 * kh + r) * QP + 16 * h + kh * DK;
            const LAS unsigned char* qoth = lds + QS + (32 * (1 - kh) + r) * QP + 16 * h + kh * DK;
            bf16x8 qf[2][4];
#pragma unroll
            for (int f = 0; f < 4; ++f) qf[0][f] = *(const LAS bf16x8*)(((f >> 1) ? qoth : qown) + 32 * (f & 1));
#pragma unroll
            for (int kt = 0; kt < NT; ++kt) {
                if (kt + 1 < NT) {
#pragma unroll
                    for (int f = 0; f < 4; ++f) qf[(kt + 1) & 1][f] = *(const LAS bf16x8*)(((f >> 1) ? qoth : qown) + 64 * (kt + 1) + 32 * (f & 1));
                }
                bf16x8 xs[2];
#pragma unroll
                for (int s2 = 0; s2 < 2; ++s2) {
                    u32x4 p; p.x = pk_bf16(S[kt][8 * s2], S[kt][8 * s2 + 1]); p.y = pk_bf16(S[kt][8 * s2 + 2], S[kt][8 * s2 + 3]); p.z = pk_bf16(S[kt][8 * s2 + 4], S[kt][8 * s2 + 5]); p.w = pk_bf16(S[kt][8 * s2 + 6], S[kt][8 * s2 + 7]);
                    const auto sw0 = __builtin_amdgcn_permlane32_swap(p.x, p.z, false, false); p.x = sw0[0]; p.z = sw0[1];
                    const auto sw1 = __builtin_amdgcn_permlane32_swap(p.y, p.w, false, false); p.y = sw1[0]; p.w = sw1[1];
                    xs[s2] = __builtin_bit_cast(bf16x8, p);
                }
                keep = MFMA32(qf[kt & 1][0], xs[0], keep);
                send = MFMA32(qf[kt & 1][2], xs[0], send);
                keep = MFMA32(qf[kt & 1][1], xs[1], keep);
                send = MFMA32(qf[kt & 1][3], xs[1], send);
            }
        }
        { LAS f32x4* xp = (LAS f32x4*)(lds + XS + v * 4096) + lane;
#pragma unroll
          for (int g = 0; g < 4; ++g) xp[g * 64] = (f32x4){send[4 * g], send[4 * g + 1], send[4 * g + 2], send[4 * g + 3]}; }
        if (v >= 4 && n > 0) SCAN_FLUSH(n - 1);
        __syncthreads();
        const unsigned blk = (lane >> 4) & 1, q4 = (lane & 15) >> 2, p4 = lane & 3;
        const unsigned trow = (8u * h + q4) * 256u + 8u * (p4 & 1), lowch = 2u * blk + (p4 >> 1);
        const unsigned xt0 = ((q4 << 2) | (2u * h)), xt1 = xt0 | 1u;
#define TRA(base, ks, c, t) tr4((base) + ((c) >> 2) * 16384 + (ks) * 4096 + (t) * 1024 + trow + 16u * (((4u * ((c) & 3u)) + lowch) ^ ((t) ? xt1 : xt0)))
#define TRF(base, ks, c) __builtin_shufflevector(TRA(base, ks, c, 0), TRA(base, ks, c, 1), 0, 1, 2, 3, 4, 5, 6, 7)
        bf16x8 vb[4];
#pragma unroll
        for (int ks = 0; ks < 4; ++ks) { const LAS unsigned char* vl = lds + VS + (8 * h + q4) * VP + blk * 32 + p4 * 8 + et * 64 + ks * (16 * VP);
            vb[ks] = __builtin_shufflevector(tr4(vl), tr4(vl + 4 * VP), 0, 1, 2, 3, 4, 5, 6, 7); }
        f32x4 xv[4];
        { const LAS f32x4* xp = (const LAS f32x4*)(lds + XS + (v ^ 4) * 4096) + lane;
#pragma unroll
          for (int g = 0; g < 4; ++g) xv[g] = xp[g * 64]; }
        {
            bf16x8 kf[2][4];
            const int c0 = (kh * (DK / 2)) >> 5;
#pragma unroll
            for (int ks = 0; ks < 4; ++ks) kf[0][ks] = TRF(lds + KS, ks, c0);
#pragma unroll
            for (int kt = 0; kt < NT; ++kt) {
                if (kt + 1 < NT) {
#pragma unroll
                    for (int ks = 0; ks < 4; ++ks) kf[(kt + 1) & 1][ks] = TRF(lds + KS, ks, c0 + kt + 1);
                }
#pragma unroll
                for (int ks = 0; ks < 4; ++ks) S[kt] = MFMA32(kf[kt & 1][ks], vb[ks], S[kt]);
            }
        }
#pragma unroll
        for (int g = 0; g < 4; ++g) { keep[4 * g] += xv[g][0]; keep[4 * g + 1] += xv[g][1]; keep[4 * g + 2] += xv[g][2]; keep[4 * g + 3] += xv[g][3]; }
        {
            bf16x8 pa[4];
#pragma unroll
            for (int s = 0; s < 4; ++s) if (s < 2 * (kh + 1)) pa[s] = *(const LAS bf16x8*)(lds + PS + (32 * kh + r) * 144 + (16 * s + 8 * h) * 2);
#pragma unroll
            for (int s = 0; s < 4; ++s) if (s < 2 * (kh + 1)) keep = MFMA32(pa[s], vb[s], keep);
        }
#pragma unroll
        for (int kt = 0; kt < NT; ++kt) {
            if (GLA) {
                const LAS float* gp = (const LAS float*)(lds + GS) + kh * (DK / 2) + 32 * kt + 4 * h;
#pragma unroll
                for (int g = 0; g < 4; ++g) { const f32x4 gv = *(const LAS f32x4*)(gp + 8 * g); S[kt][4 * g] *= gv[0]; S[kt][4 * g + 1] *= gv[1]; S[kt][4 * g + 2] *= gv[2]; S[kt][4 * g + 3] *= gv[3]; }
            } else {
#pragma unroll
                for (int i = 0; i < 16; ++i) S[kt][i] *= g64;
            }
        }
        { LAS bf16_t* op = (LAS bf16_t*)(lds + OS);
#pragma unroll
          for (int i = 0; i < 16; ++i) { const int row = 32 * kh + (i & 3) + 8 * (i >> 2) + 4 * h; op[row * 136 + 32 * et + r] = (bf16_t)(pk_bf16(keep[i], 0.f) & 0xffffu); } }
#undef TRA
#undef TRF
#undef ROWA
        __syncthreads();
    }
    if (v >= 4) SCAN_FLUSH(NCHUNK - 1);
    __syncthreads();
}

#define XB_TMO      128
#define XB_XCNT(j)  (256  + 64 * (j))
#define XB_XSUB(j)  (1280 + 64 * (j))
#define XB_XGEN(j)  (2304 + 64 * (j))
#define XB_TOP      3328
#define XB_TOPGEN   3392
#define XCD_BAR_WORDS 3456
#define XB_SPIN_CAP (1u << 20)
DI unsigned xb_ld(unsigned* p)              { return __hip_atomic_load(p, __ATOMIC_RELAXED, __HIP_MEMORY_SCOPE_AGENT); }
DI unsigned xb_add(unsigned* p, unsigned v) { return __hip_atomic_fetch_add(p, v, __ATOMIC_RELAXED, __HIP_MEMORY_SCOPE_AGENT); }
DI unsigned xb_xcc_id() { return (unsigned)__builtin_amdgcn_s_getreg((3 << 11) | 20) & 0xFu; }
#define XB_SPIN(cond, bar) do { unsigned _sp = 0; while (cond) { __builtin_amdgcn_s_sleep(1); \
    if ((++_sp & 255u) == 0u) { if (xb_ld(&(bar)[XB_TMO])) break; if (_sp > XB_SPIN_CAP) { atomicAdd(&(bar)[XB_TMO], 1u); break; } } } } while (0)
struct XcdBarrier { unsigned* bar; unsigned x; volatile LAS unsigned* st; };
DI XcdBarrier xcd_barrier_post(unsigned* bar, volatile LAS unsigned* st) {
    XcdBarrier b; b.bar = bar; b.x = xb_xcc_id(); b.st = st;
    if (threadIdx.x == 0) (void)xb_add(&bar[XB_XCNT(b.x)], 1u);
    return b;
}
DI void xcd_barrier_complete(unsigned* bar, unsigned x, unsigned& nloc, unsigned& nx) {
    const unsigned G = gridDim.x * gridDim.y * gridDim.z;
    unsigned sum, cnt, mine, sp = 0u;
    for (;;) {
        sum = 0u; cnt = 0u; mine = 0u;
#pragma unroll
        for (unsigned j = 0; j < 16; ++j) { const unsigned c = xb_ld(&bar[XB_XCNT(j)]); sum += c; cnt += (c > 0u) ? 1u : 0u; mine = (j == x) ? c : mine; }
        if (sum == G) break;
        __builtin_amdgcn_s_sleep(1);
        if ((++sp & 255u) == 0u) { if (xb_ld(&bar[XB_TMO])) break; if (sp > XB_SPIN_CAP) { atomicAdd(&bar[XB_TMO], 1u); break; } }
    }
    nloc = mine > 0u ? mine : 1u; nx = cnt > 0u ? cnt : 1u;
}
DI void xcd_barrier(const XcdBarrier& b) {
    asm volatile("s_waitcnt vmcnt(0)" ::: "memory");
    __syncthreads();
    if (threadIdx.x == 0) {
        unsigned* bar = b.bar;
        __builtin_amdgcn_s_waitcnt(0);
        unsigned nloc = b.st[0], nx = b.st[1];
        if (nloc == 0u) { xcd_barrier_complete(bar, b.x, nloc, nx); b.st[0] = nloc; b.st[1] = nx; }
        const unsigned old = xb_add(&bar[XB_XSUB(b.x)], 1u);
        const unsigned gen = old / nloc;
        if (old + 1u == (gen + 1u) * nloc) {
            __builtin_amdgcn_fence(__ATOMIC_RELEASE, "agent");
            asm volatile("s_waitcnt vmcnt(0)" ::: "memory");
            const unsigned og = xb_add(&bar[XB_TOP], 1u);
            const unsigned tg = og / nx;
            if (og + 1u == (tg + 1u) * nx) xb_add(&bar[XB_TOPGEN], 1u);
            else XB_SPIN(xb_ld(&bar[XB_TOPGEN]) == tg, bar);
            __builtin_amdgcn_fence(__ATOMIC_ACQUIRE, "agent");
            xb_add(&bar[XB_XGEN(b.x)], 1u);
            asm volatile("s_waitcnt vmcnt(0)" ::: "memory");
        } else {
            XB_SPIN(xb_ld(&bar[XB_XGEN(b.x)]) == gen, bar);
            __builtin_amdgcn_fence(__ATOMIC_ACQUIRE, "agent");
            asm volatile("s_waitcnt vmcnt(0)" ::: "memory");
        }
    }
    __syncthreads();
}
constexpr int MISC_OFF = LDS_BYTES - 256;

struct Args { const float* in[12]; float* out; unsigned char* ws; int ph_lo, ph_hi; };
#ifndef MK_PROBE
#define MK_PROBE 0
#endif
#ifndef MK_STAGGER
#define MK_STAGGER 0
#endif

DI float wave_sum(float v) {
#pragma unroll
    for (int o = 1; o < 64; o <<= 1) v += __shfl_xor(v, o);
    return v;
}
DI void transpose_item(const float* W, int N, bf16_t* WT, int dpitch, int koff, int k0, int scol0, int drow0, LAS float* scr, int lane) {
#pragma unroll 8
    for (int i = 0; i < 32; ++i) { const int kk = 2 * i + (lane >> 5); scr[kk * 33 + (lane & 31)] = W[(size_t)(k0 + kk) * N + scol0 + (lane & 31)]; }
    asm volatile("s_waitcnt lgkmcnt(0)" ::: "memory");
    const int c = lane & 7;
#pragma unroll
    for (int j = 0; j < 4; ++j) { const int n = (lane >> 3) + 8 * j; const LAS float* s = scr + (8 * c) * 33 + n;
        u32x4 o; o.x = pk_bf16(s[0 * 33], s[1 * 33]); o.y = pk_bf16(s[2 * 33], s[3 * 33]); o.z = pk_bf16(s[4 * 33], s[5 * 33]); o.w = pk_bf16(s[6 * 33], s[7 * 33]);
        *(u32x4*)(WT + (size_t)(drow0 + n) * dpitch + koff + k0 + 8 * c) = o; }
    asm volatile("s_waitcnt lgkmcnt(0)" ::: "memory");
}

__global__ void __launch_bounds__(512, 2) mk_fwd(Args a) {
    extern __shared__ __attribute__((aligned(16))) unsigned char lds_raw[];
    LAS unsigned char* lds = (LAS unsigned char*)lds_raw;
    unsigned char* ws = a.ws;
    const float* x = a.in[0]; const float* meta = a.in[1]; const float* norm_gain = a.in[2]; const float* w_in = a.in[3];
    const float* w_gate_up = a.in[4]; const float* b_gate = a.in[5]; const float* ret_gain = a.in[6]; const float* gla_gain = a.in[7];
    const float* w_br = a.in[8]; const float* w_bg = a.in[9]; const float* w_out = a.in[10]; const float* fgain = a.in[11];
    bf16_t* srg = (bf16_t*)a.out;
#if MK_N_LAUNCHES == 1
    { volatile LAS unsigned* misc = (volatile LAS unsigned*)(lds + MISC_OFF); if (threadIdx.x < 64) misc[threadIdx.x] = 0u; }
    __syncthreads();
    const XcdBarrier xbar = xcd_barrier_post((unsigned*)(ws + WS_CTL), (volatile LAS unsigned*)(lds + MISC_OFF));
#define GRID_SYNC(k) do { if (a.ph_hi > 64) cg::this_grid().sync(); else xcd_barrier(xbar); } while (0)
#else
#define GRID_SYNC(k) do {} while (0)
#endif
#define PH_BEGIN(k) if (a.ph_lo <= (k) && (k) < a.ph_hi) { \
        int bxo = blockIdx.x, Go = gridDim.x, tid = threadIdx.x; asm volatile("" : "+s"(bxo), "+s"(Go), "+v"(tid)); \
        const int lane = tid & 63, wave = __builtin_amdgcn_readfirstlane(tid >> 6), G = Go, bx = bxo; \
        const int vcu = (G % 8 == 0) ? (bx % 8) * (G / 8) + bx / 8 : bx; (void)lane; (void)wave; (void)vcu;
#define PH_END(k) if ((k) + 1 < a.ph_hi) GRID_SYNC(k); }
    {
        PH_BEGIN(0)
          for (int rep = 0; rep < (MK_PROBE == 3 ? 2 : 1); ++rep) {
            const int gw = vcu * 8 + wave, NGW = G * 8;
            const size_t gt = (size_t)vcu * 512 + tid, NGT = (size_t)G * 512;
            { u32x4* z = (u32x4*)(ws + WS_ROWSS); const size_t nz = (WS_ROPE - WS_ROWSS) / 16; for (size_t i = gt; i < nz; i += NGT) z[i] = (u32x4){0u, 0u, 0u, 0u}; }
            LAS float* scr = (LAS float*)(lds + wave * 16384);
            constexpr int I1 = 16 * 256, I1B = 16 * 96, I3R = 32 * 32, I3G = 16 * 32, I4 = 16 * 32;
            for (int it = gw; it < I1 + I1B + I3R + I3G + I4; it += NGW) {
                int q = it;
                if (q < I1) { const int kb = q / 256, nb = q % 256, n0 = 32 * nb; const int sc = n0 < 4096 ? n0 : (n0 < 6144 ? n0 + 2048 : n0 + 3088);
                    transpose_item(w_in, IN_COLS, (bf16_t*)(ws + WS_BT1), 1024, 0, 64 * kb, sc, n0, scr, lane); continue; } q -= I1;
                if (q < I1B) { const int kb = q / 96, nb = q % 96, n0 = 32 * nb; const int sc = n0 < 2048 ? n0 + 4096 : n0 + 6144;
                    transpose_item(w_in, IN_COLS, (bf16_t*)(ws + WS_BT1B), 1024, 0, 64 * kb, sc, n0, scr, lane); continue; } q -= I1B;
                if (q < I3R) { const int kb = q / 32, nb = q % 32; transpose_item(w_br, 1024, (bf16_t*)(ws + WS_BT3), 3072, 0, 64 * kb, 32 * nb, 32 * nb, scr, lane); continue; } q -= I3R;
                if (q < I3G) { const int kb = q / 32, nb = q % 32; transpose_item(w_bg, 1024, (bf16_t*)(ws + WS_BT3), 3072, 2048, 64 * kb, 32 * nb, 32 * nb, scr, lane); continue; } q -= I3G;
                { const int kb = q / 32, nb = q % 32; transpose_item(w_out, 1024, (bf16_t*)(ws + WS_BT4), 1024, 0, 64 * kb, 32 * nb, 32 * nb, scr, lane); }
            }
            for (size_t i = gt; i < (size_t)512 * 128; i += NGT) { const int n = (int)(i >> 7), k0 = (int)(i & 127) * 8; float up[16];
#pragma unroll
                for (int rr = 0; rr < 16; ++rr) up[rr] = w_gate_up[rr * 512 + n];
                float o[8];
#pragma unroll
                for (int j = 0; j < 8; ++j) { const float* wr_ = w_in + (size_t)(k0 + j) * IN_COLS + 9216; float s = 0.f;
#pragma unroll
                    for (int rr = 0; rr < 16; ++rr) s += wr_[rr] * up[rr];
                    o[j] = s; }
                u32x4 w; w.x = pk_bf16(o[0], o[1]); w.y = pk_bf16(o[2], o[3]); w.z = pk_bf16(o[4], o[5]); w.w = pk_bf16(o[6], o[7]);
                *(u32x4*)((bf16_t*)(ws + WS_BT1) + (size_t)(8192 + n) * 1024 + k0) = w; }
            if (gt < 128) { const int d = (int)gt; double pw = 1.0, bs = 0.9305720409296989;
                for (int e = d; e; e >>= 1) { if (e & 1) pw *= bs; bs *= bs; }
                const float invf = (float)pw; const double c = (double)invf * 0.15915494309189535;
                const float chi = __uint_as_float(__float_as_uint((float)c) & 0xFFFFC000u); const float clo = (float)(c - (double)chi);
                ((f32x2*)(ws + WS_ROPE))[d] = (f32x2){chi, clo}; }
            bf16_t* U = (bf16_t*)(ws + WS_U);
            for (int m = gw; m < ROWS; m += NGW) {
                const int b = m / LP, p = m - b * LP;
                unsigned long long* o8 = (unsigned long long*)(U + (size_t)m * D) + lane;
                if (p < PADF) {
#pragma unroll
                    for (int j = 0; j < 4; ++j) o8[64 * j] = 0ull;
                    continue; }
                const float* src = p < 64 ? meta + (size_t)(p - PADF) * D : x + ((size_t)b * SEQ + (p - 64)) * D;
                const f32x4* xr = (const f32x4*)src + lane; const f32x4* gr = (const f32x4*)norm_gain + lane;
                f32x4 vv[4]; float s = 0.f;
#pragma unroll
                for (int j = 0; j < 4; ++j) { vv[j] = xr[64 * j]; s += (vv[j].x * vv[j].x + vv[j].y * vv[j].y) + (vv[j].z * vv[j].z + vv[j].w * vv[j].w); }
                const float rstd = 1.0f / sqrtf(wave_sum(s) * (1.0f / D) + EPS);
#pragma unroll
                for (int j = 0; j < 4; ++j) { const f32x4 gg = gr[64 * j]; const f32x4 y = vv[j] * rstd * gg;
                    o8[64 * j] = (unsigned long long)pk_bf16(y.x, y.y) | ((unsigned long long)pk_bf16(y.z, y.w) << 32); }
            }
          }
        PH_END(0)
        PH_BEGIN(1)
          for (int rep = 0; rep < (MK_PROBE == 1 ? 2 : 1); ++rep) {
            pg8::Gemm g{(const bf16_t*)(ws + WS_U), (const bf16_t*)(ws + WS_BT1), ROWS, N1, 1024, 0}; pg8::P1Order S; S.init(Go, bxo);
            EpiProj E{ws, srg, b_gate, 0};
            pg8::gemm_phase<EpiProj, pg8::P1Order>(lds, g, S, E, tid, MK_STAGGER);
          }
#if MK_PROBE == 5
            { pg8::Gemm g{(const bf16_t*)(ws + WS_U), (const bf16_t*)(ws + WS_BT1), ROWS, N1, 1024, 0}; pg8::StaticOrder S; S.init(ROWS, N1, Go, bxo);
              int ns = 1; asm volatile("" : "+s"(ns)); EpiProj E{ws, srg, b_gate, ns}; pg8::gemm_phase<EpiProj, pg8::StaticOrder>(lds, g, S, E, tid, MK_STAGGER); }
#endif
#if MK_PROBE == 4
            { pg8::Gemm g{(const bf16_t*)(ws + WS_U), (const bf16_t*)(ws + WS_BT1), ROWS, N1, 1024, 0}; pg8::StaticOrder S; S.init(ROWS, N1, Go, bxo);
              EpiDry E{}; pg8::gemm_phase<EpiDry, pg8::StaticOrder>(lds, g, S, E, tid, MK_STAGGER); }
#endif
        PH_END(1)
#define SCAN_BODY(DRY, MASK) do { \
            const int xcd = bxo & 7, j = bxo >> 3; \
            float* stats = (float*)(ws + WS_STATS); \
            if (G == 256 && j < 16 && ((MASK) & 1)) { \
                const int u = xcd * 16 + j, b = u >> 4, hh = (u >> 2) & 3, es = u & 3; \
                const size_t r0 = (size_t)b * LP; \
                const float g64 = exp2f(64.0f * __log2f(1.0f - exp2f(-5.0f - (float)hh))); \
                scan_unit<256, false>(lds, (const bf16_t*)(ws + WS_RQ) + r0 * 1024 + hh * 256, (const bf16_t*)(ws + WS_RK) + r0 * 1024 + hh * 256, \
                                      (bf16_t*)(ws + WS_RV) + r0 * 2048 + hh * 512 + es * 128, nullptr, stats + r0 * 48 + (hh * 4 + es) * 2, 1024, 2048, g64, tid, DRY); \
            } else if (G == 256 && j >= 16 && j < 24 && ((MASK) & 2)) { \
                const int u = xcd * 8 + (j - 16), b = u >> 3, hh = (u >> 1) & 3, es = u & 1; \
                const size_t r0 = (size_t)b * LP; \
                scan_unit<128, true>(lds, (const bf16_t*)(ws + WS_GQ) + r0 * 512 + hh * 128, (const bf16_t*)(ws + WS_GK) + r0 * 512 + hh * 128, \
                                     (bf16_t*)(ws + WS_GV) + r0 * 1024 + hh * 256 + es * 128, (const bf16_t*)(ws + WS_LA) + r0 * 512 + hh * 128, stats + r0 * 48 + (16 + hh * 2 + es) * 2, 512, 1024, 1.0f, tid, DRY); \
            } } while (0)
#if MK_PROBE == 2 || MK_PROBE == 6 || MK_PROBE == 7
        PH_BEGIN(2)
            int dry = 1, msk = (MK_PROBE == 2 ? 3 : (MK_PROBE == 6 ? 1 : 2)); asm volatile("" : "+s"(dry), "+s"(msk));
            SCAN_BODY(dry, msk);
        }
#endif
        PH_BEGIN(2)
            int dry = 0; asm volatile("" : "+s"(dry));
            SCAN_BODY(dry, 3);
            {
                const int xcd = bxo & 7, j = bxo >> 3; int sstart = 0, scount = 0;
                if (G == 256 && j >= 24) { const int k = xcd * 8 + (j - 24); sstart = 16 * k; scount = 16; }
                else if (G == 256 && j >= 16) { const int k = xcd * 8 + (j - 16); if (k < 52) { sstart = 1024 + k; scount = 1; } }
                if (scount > 0) {
                    pg8::Gemm g{(const bf16_t*)(ws + WS_U), (const bf16_t*)(ws + WS_BT1), ROWS, N1, 1024, 0}; pg8::SideOrder S{sstart, scount};
                    EpiProj E{ws, srg, b_gate, 0};
                    pg8::gemm_phase<EpiProj, pg8::SideOrder>(lds, g, S, E, tid, 0);
                }
            }
        PH_END(2)
        PH_BEGIN(3)
            static_assert(WS_BT1B == WS_BT1 + (size_t)N1 * 1024 * 2, "gate weights follow the projection weights: one fused [N][K] copy");
            pg8::Gemm g{(const bf16_t*)(ws + WS_U), (const bf16_t*)(ws + WS_BT1), CROWS, N1 + N1B, 1024, 1};
            pg8::P3Order S; S.in.init(CROWS, N1B, Go, bxo, 1); S.pre = ((bxo >> 3) & 7) >> 1; S.sbase = pg8::SIDE_X + 3 * bxo;
            EpiP3 E{EpiProj{ws, srg, b_gate, 0}, EpiGate{ws, ret_gain, gla_gain, (LAS float*)(lds + SSL_OFF)}};
            pg8::gemm_phase<EpiP3, pg8::P3Order>(lds, g, S, E, tid, 0);
        PH_END(3)
        PH_BEGIN(4)
            pg8::Gemm g{(const bf16_t*)(ws + WS_RQ), (const bf16_t*)(ws + WS_BT3), CROWS, 1024, 3072, 0}; pg8::StaticOrder S; S.init(CROWS, 1024, Go, bxo);
            EpiMerge E{(const unsigned char*)srg, (bf16_t*)(ws + WS_U)};
            pg8::gemm_phase<EpiMerge, pg8::StaticOrder>(lds, g, S, E, tid, MK_STAGGER);
        PH_END(4)
        PH_BEGIN(5)
            pg8::Gemm g{(const bf16_t*)(ws + WS_U), (const bf16_t*)(ws + WS_BT4), CROWS, 1024, 1024, 0}; pg8::PanelOrder S{bxo};
            LAS float* ssl = (LAS float*)(lds + SSL_OFF);
            bf16_t* yb = (bf16_t*)(ws + WS_RQ);
            EpiOut E{x, yb, ssl};
            if (G == 256) pg8::gemm_phase<EpiOut, pg8::PanelOrder>(lds, g, S, E, tid, MK_STAGGER);
            __syncthreads();
            for (int r0 = wave * 32; r0 < wave * 32 + 32; r0 += 4) {
                u32x4 vv[4][2]; float rstd[4];
#pragma unroll
                for (int q = 0; q < 4; ++q) {
                    const u32x4* yr = (const u32x4*)(yb + ((size_t)bxo * 256 + r0 + q) * D) + lane;
                    vv[q][0] = __builtin_nontemporal_load(yr); vv[q][1] = __builtin_nontemporal_load(yr + 64);
                    float ss = 0.f;
#pragma unroll
                    for (int k = 0; k < 16; ++k) ss += ssl[k * 256 + r0 + q];
                    rstd[q] = 1.0f / sqrtf(ss * (1.0f / D) + EPS);
                }
#pragma unroll
                for (int q = 0; q < 4; ++q)
#pragma unroll
                    for (int hh = 0; hh < 2; ++hh) {
                        const int e0 = hh * 512 + lane * 8;
                        const f32x4 g0 = *(const f32x4*)(fgain + e0), g1 = *(const f32x4*)(fgain + e0 + 4);
                        const u32x4 w = vv[q][hh];
                        const f32x4 o0 = (f32x4){bf_lo(w.x), bf_hi(w.x), bf_lo(w.y), bf_hi(w.y)} * rstd[q] * g0, o1 = (f32x4){bf_lo(w.z), bf_hi(w.z), bf_lo(w.w), bf_hi(w.w)} * rstd[q] * g1;
                        float* orow = a.out + ((size_t)bxo * 256 + r0 + q) * D + e0;
                        *(f32x4*)orow = o0; *(f32x4*)(orow + 4) = o1;
                    }
            }
        PH_END(5)
    }
}

constexpr int N_PHASES = 6;
extern "C" void kernel_launch(void* const* d_in, const int* in_sizes, int n_in, void* d_out, int out_size, void* d_ws, size_t ws_size, hipStream_t stream) {
    static int grid = 0;
    if (grid == 0) {
        if (n_in != 12 || in_sizes[0] != CROWS * D || out_size != CROWS * D || ws_size < WS_END) {
            fprintf(stderr, "kernel_launch: unexpected shapes (n_in %d, in0 %d, out %d, ws %zu; need ws >= %zu); nothing launched\n", n_in, n_in > 0 ? in_sizes[0] : -1, out_size, ws_size, (size_t)WS_END); grid = -1; return; }
        int dev = 0, cus = 0, per_cu = 0;
        if (hipGetDevice(&dev) != hipSuccess || hipDeviceGetAttribute(&cus, hipDeviceAttributeMultiprocessorCount, dev) != hipSuccess) { fprintf(stderr, "kernel_launch: device query failed\n"); grid = -1; return; }
        if (hipFuncSetAttribute((const void*)mk_fwd, hipFuncAttributeMaxDynamicSharedMemorySize, LDS_BYTES) != hipSuccess) { fprintf(stderr, "kernel_launch: hipFuncSetAttribute failed\n"); grid = -1; return; }
        if (hipOccupancyMaxActiveBlocksPerMultiprocessor(&per_cu, (const void*)mk_fwd, 512, LDS_BYTES) != hipSuccess || per_cu < 1) { fprintf(stderr, "kernel_launch: occupancy query says %d blocks per CU\n", per_cu); (void)hipGetLastError(); grid = -1; return; }
        grid = cus;
        if (grid != 256) fprintf(stderr, "kernel_launch: note: %d CUs (the scan phase is laid out for 256)\n", grid);
    }
    if (grid < 0) return;
    Args a{};
    for (int i = 0; i < 12; ++i) a.in[i] = (const float*)d_in[i];
    a.out = (float*)d_out; a.ws = (unsigned char*)d_ws;
#if MK_N_LAUNCHES == 1
    if (hipMemsetAsync((char*)d_ws + WS_CTL, 0, 65536, stream) != hipSuccess) { fprintf(stderr, "kernel_launch: memset of the control words failed\n"); return; }
    a.ph_lo = 0; a.ph_hi = N_PHASES;
    void* args[] = {&a};
    hipError_t e = hipLaunchCooperativeKernel((const void*)mk_fwd, dim3(grid), dim3(512), args, LDS_BYTES, stream);
    if (e != hipSuccess) fprintf(stderr, "kernel_launch: cooperative launch failed: %s (grid %d)\n", hipGetErrorString(e), grid);
#else
    for (int p = 0; p < N_PHASES; ++p) {
        a.ph_lo = p; a.ph_hi = p + 1;
        hipLaunchKernelGGL(mk_fwd, dim3(grid), dim3(512), LDS_BYTES, stream, a);
    }
#endif
}
```
